# Optimizing an MI355X kernel written in HIP

```python
import math
import jax, jax.numpy as jnp
from jax import lax
import numpy as np

D_MODEL = 1024
BATCH = 8
SEQ = 2048
DEPTH = 2

N_MIXERS = 2
BRANCH_WIDTH = 2 * D_MODEL
XQ_WIDTH = BRANCH_WIDTH // 4
PRIMARY_WIDTH = BRANCH_WIDTH - XQ_WIDTH
MEM_LEN = 256
X_HEADS = 4
X_HEAD_DIM = XQ_WIDTH // X_HEADS
S5_GROUP_CH = 16
S5_GROUPS = PRIMARY_WIDTH // S5_GROUP_CH
S5_STATE = 64
S5_STEP_MIN = 1e-3
S5_STEP_MAX = 1e-1
MLA_NOPE = 128
MLA_ROPE = 64
MLA_V = 128
MLA_HEADS = PRIMARY_WIDTH // MLA_V
MLA_Q_LORA = D_MODEL // 2
MLA_KV_LORA = D_MODEL // 4
ROPE_THETA = 10000.0
Q_BLOCK = 128
EPS = 1e-6
N_S5 = (DEPTH + 1) // 2
N_MLA = DEPTH // 2
S5_IN_WIDTH = PRIMARY_WIDTH + XQ_WIDTH + BRANCH_WIDTH
MLA_IN_WIDTH = MLA_Q_LORA + MLA_KV_LORA + MLA_ROPE + XQ_WIDTH + BRANCH_WIDTH

kernel_name = "hybrid_s5_mla_memory_block"


def rms_norm(x, g):
    xf = x.astype(jnp.float32)
    y = xf * lax.rsqrt(jnp.mean(xf * xf, axis=-1, keepdims=True) + EPS)
    return (y * g.astype(jnp.float32)).astype(x.dtype)


def rotary_tables(positions):
    half = MLA_ROPE // 2
    inv_freq = ROPE_THETA ** (-jnp.arange(half, dtype=jnp.float32) / half)
    ang = positions.astype(jnp.float32)[:, :, None, None] * inv_freq
    return jnp.cos(ang), jnp.sin(ang)


def rotary(x, cos, sin):
    x1, x2 = jnp.split(x.astype(jnp.float32), 2, axis=-1)
    return jnp.concatenate([x1 * cos - x2 * sin, x1 * sin + x2 * cos], axis=-1).astype(x.dtype)


def _ssm_combine(left, right):
    a_l, b_l = left
    a_r, b_r = right
    return a_l * a_r, a_r * b_l + b_r


def s5_mix(u, lam_re, lam_im, log_step, b_re, b_im, c_re, c_im, d):
    bsz, seq, _ = u.shape
    f32 = jnp.float32
    uf = u.astype(f32).reshape(bsz, seq, S5_GROUPS, S5_GROUP_CH)
    lam = lax.complex(lam_re.astype(f32), lam_im.astype(f32))
    step = jnp.exp(log_step.astype(f32))[:, None]
    a_bar = jnp.exp(lam * step)
    b_mat = lax.complex(b_re.astype(f32), b_im.astype(f32))
    c_mat = lax.complex(c_re.astype(f32), c_im.astype(f32))
    b_bar = ((a_bar - 1.0) / lam)[..., None] * b_mat
    bu = jnp.einsum('blgc,gpc->blgp', uf.astype(jnp.complex64), b_bar)
    a_seq = jnp.broadcast_to(a_bar, (1, seq) + a_bar.shape)
    _, state = lax.associative_scan(_ssm_combine, (a_seq, bu), axis=1)
    y = jnp.einsum('blgp,gcp->blgc', state, c_mat).real + d.astype(f32).reshape(S5_GROUPS, S5_GROUP_CH) * uf
    return y.reshape(bsz, seq, PRIMARY_WIDTH).astype(u.dtype)


def causal_block_attention(q, k, v, scale):
    bsz, seq, heads, dk = q.shape
    dv = v.shape[-1]
    n_blocks = seq // Q_BLOCK
    q_blocks = q.reshape(bsz, n_blocks, Q_BLOCK, heads, dk).transpose(1, 0, 2, 3, 4)
    k_pos = jnp.arange(seq)

    def one_block(args):
        q_blk, blk = args
        s = jnp.einsum('bqhd,bkhd->bhqk', q_blk, k).astype(jnp.float32) * scale
        q_pos = blk * Q_BLOCK + jnp.arange(Q_BLOCK)
        s = jnp.where(k_pos[None, :] <= q_pos[:, None], s, jnp.finfo(jnp.float32).min)
        p = jax.nn.softmax(s, axis=-1).astype(v.dtype)
        return jnp.einsum('bhqk,bkhd->bqhd', p, v)

    out = lax.map(one_block, (q_blocks, jnp.arange(n_blocks)))
    return out.transpose(1, 0, 2, 3, 4).reshape(bsz, seq, heads, dv)


def memory_attention(xq, mem, mem_norm, w_mem_kv, xq_norm, xk_norm):
    bsz, seq, _ = xq.shape
    kv = rms_norm(mem, mem_norm) @ w_mem_kv
    k, v = jnp.split(kv, 2, axis=-1)
    k = rms_norm(k.reshape(bsz, -1, X_HEADS, X_HEAD_DIM), xk_norm)
    v = v.reshape(bsz, -1, X_HEADS, X_HEAD_DIM)
    q = rms_norm(xq.reshape(bsz, seq, X_HEADS, X_HEAD_DIM), xq_norm)
    s = jnp.einsum('blhd,bmhd->bhlm', q, k).astype(jnp.float32) * (X_HEAD_DIM ** -0.5)
    p = jax.nn.softmax(s, axis=-1).astype(v.dtype)
    return jnp.einsum('bhlm,bmhd->blhd', p, v).reshape(bsz, seq, XQ_WIDTH)


def merge_branches(x, mixer_out, xq, gate, mem, w_out, mem_norm, w_mem_kv, xq_norm, xk_norm):
    mem_out = memory_attention(xq, mem, mem_norm, w_mem_kv, xq_norm, xk_norm)
    o = jnp.concatenate([mixer_out, mem_out], axis=-1) * jax.nn.silu(gate)
    return x + o @ w_out


def s5_layer(x, mem, ln, w_in, lam_re, lam_im, log_step, b_re, b_im, c_re, c_im, d, w_glu,
             w_out, mem_norm, w_mem_kv, xq_norm, xk_norm):
    proj = rms_norm(x, ln) @ w_in
    u, xq, gate = jnp.split(proj, [PRIMARY_WIDTH, PRIMARY_WIDTH + XQ_WIDTH], axis=-1)
    y = s5_mix(u, lam_re, lam_im, log_step, b_re, b_im, c_re, c_im, d)
    y_a, y_b = jnp.split(jax.nn.gelu(y) @ w_glu, 2, axis=-1)
    y = y_a * jax.nn.sigmoid(y_b)
    return merge_branches(x, y, xq, gate, mem, w_out, mem_norm, w_mem_kv, xq_norm, xk_norm)


def mla_layer(x, mem, cos, sin, ln, w_in, q_lora_norm, kv_lora_norm, w_uq, w_ukv,
              q_nope_norm, k_nope_norm, q_rope_norm, k_rope_norm,
              w_out, mem_norm, w_mem_kv, xq_norm, xk_norm):
    bsz, seq, _ = x.shape
    proj = rms_norm(x, ln) @ w_in
    o1 = MLA_Q_LORA
    o2 = o1 + MLA_KV_LORA
    o3 = o2 + MLA_ROPE
    o4 = o3 + XQ_WIDTH
    c_q, c_kv, k_rope, xq, gate = jnp.split(proj, [o1, o2, o3, o4], axis=-1)
    q = (rms_norm(c_q, q_lora_norm) @ w_uq).reshape(bsz, seq, MLA_HEADS, MLA_NOPE + MLA_ROPE)
    kv = (rms_norm(c_kv, kv_lora_norm) @ w_ukv).reshape(bsz, seq, MLA_HEADS, MLA_NOPE + MLA_V)
    q_nope, q_rope = q[..., :MLA_NOPE], q[..., MLA_NOPE:]
    k_nope, v = kv[..., :MLA_NOPE], kv[..., MLA_NOPE:]
    q_rope = rotary(rms_norm(q_rope, q_rope_norm), cos, sin)
    k_rope = rotary(rms_norm(k_rope.reshape(bsz, seq, 1, MLA_ROPE), k_rope_norm), cos, sin)
    q_full = jnp.concatenate([rms_norm(q_nope, q_nope_norm), q_rope], axis=-1)
    k_full = jnp.concatenate([rms_norm(k_nope, k_nope_norm),
                              jnp.broadcast_to(k_rope, (bsz, seq, MLA_HEADS, MLA_ROPE))], axis=-1)
    attn = causal_block_attention(q_full, k_full, v, (MLA_NOPE + MLA_ROPE) ** -0.5)
    attn = attn.reshape(bsz, seq, PRIMARY_WIDTH)
    return merge_branches(x, attn, xq, gate, mem, w_out, mem_norm, w_mem_kv, xq_norm, xk_norm)


def setup_inputs(seed: int = 0) -> dict:
    key = jax.random.key(seed)
    k = jax.random.split(key, 32)
    f32 = jnp.float32

    def w(kk, shape, fan_in):
        return jax.random.normal(kk, shape, f32) * (fan_in ** -0.5)

    def gain(kk, shape):
        return 1.0 + 0.02 * jax.random.normal(kk, shape, f32)

    x = jax.random.normal(k[0], (BATCH, SEQ, D_MODEL), f32)
    mem = jax.random.normal(k[1], (BATCH, MEM_LEN, D_MODEL), f32)
    offsets = jax.random.randint(k[2], (BATCH, 1), 0, 4096, dtype=jnp.int32)
    positions = offsets + jnp.arange(SEQ, dtype=jnp.int32)[None, :]

    lam_im_base = math.pi * jnp.arange(S5_STATE, dtype=f32)
    return {
        "x": x,
        "mem": mem,
        "positions": positions,
        "ln_gain": gain(k[3], (DEPTH, D_MODEL)),
        "w_out": w(k[4], (DEPTH, BRANCH_WIDTH, D_MODEL), BRANCH_WIDTH),
        "mem_norm": gain(k[5], (DEPTH, D_MODEL)),
        "w_mem_kv": w(k[6], (DEPTH, D_MODEL, 2 * XQ_WIDTH), D_MODEL),
        "xq_norm": gain(k[7], (DEPTH, X_HEAD_DIM)),
        "xk_norm": gain(k[8], (DEPTH, X_HEAD_DIM)),
        "s5_w_in": w(k[9], (N_S5, D_MODEL, S5_IN_WIDTH), D_MODEL),
        "s5_lambda_re": -0.5 + 0.01 * jax.random.normal(k[10], (N_S5, S5_GROUPS, S5_STATE), f32),
        "s5_lambda_im": lam_im_base + 0.01 * jax.random.normal(k[11], (N_S5, S5_GROUPS, S5_STATE), f32),
        "s5_log_step": jax.random.uniform(k[12], (N_S5, S5_GROUPS), f32,
                                          math.log(S5_STEP_MIN), math.log(S5_STEP_MAX)),
        "s5_b_re": w(k[13], (N_S5, S5_GROUPS, S5_STATE, S5_GROUP_CH), 2 * S5_GROUP_CH),
        "s5_b_im": w(k[14], (N_S5, S5_GROUPS, S5_STATE, S5_GROUP_CH), 2 * S5_GROUP_CH),
        "s5_c_re": w(k[15], (N_S5, S5_GROUPS, S5_GROUP_CH, S5_STATE), S5_STATE),
        "s5_c_im": w(k[16], (N_S5, S5_GROUPS, S5_GROUP_CH, S5_STATE), S5_STATE),
        "s5_d": jax.random.normal(k[17], (N_S5, PRIMARY_WIDTH), f32),
        "s5_w_glu": w(k[18], (N_S5, PRIMARY_WIDTH, 2 * PRIMARY_WIDTH), PRIMARY_WIDTH),
        "mla_w_in": w(k[19], (N_MLA, D_MODEL, MLA_IN_WIDTH), D_MODEL),
        "mla_q_lora_norm": gain(k[20], (N_MLA, MLA_Q_LORA)),
        "mla_kv_lora_norm": gain(k[21], (N_MLA, MLA_KV_LORA)),
        "mla_w_uq": w(k[22], (N_MLA, MLA_Q_LORA, MLA_HEADS * (MLA_NOPE + MLA_ROPE)), MLA_Q_LORA),
        "mla_w_ukv": w(k[23], (N_MLA, MLA_KV_LORA, MLA_HEADS * (MLA_NOPE + MLA_V)), MLA_KV_LORA),
        "mla_q_nope_norm": gain(k[24], (N_MLA, MLA_NOPE)),
        "mla_k_nope_norm": gain(k[25], (N_MLA, MLA_NOPE)),
        "mla_q_rope_norm": gain(k[26], (N_MLA, MLA_ROPE)),
        "mla_k_rope_norm": gain(k[27], (N_MLA, MLA_ROPE)),
    }


def reference(x, mem, positions, ln_gain, w_out, mem_norm, w_mem_kv, xq_norm, xk_norm,
              s5_w_in, s5_lambda_re, s5_lambda_im, s5_log_step, s5_b_re, s5_b_im, s5_c_re, s5_c_im,
              s5_d, s5_w_glu, mla_w_in, mla_q_lora_norm, mla_kv_lora_norm, mla_w_uq, mla_w_ukv,
              mla_q_nope_norm, mla_k_nope_norm, mla_q_rope_norm, mla_k_rope_norm):
    cos, sin = rotary_tables(positions)
    for i in range(DEPTH):
        j = i // N_MIXERS
        if i % N_MIXERS == 0:
            x = s5_layer(x, mem, ln_gain[i], s5_w_in[j], s5_lambda_re[j], s5_lambda_im[j], s5_log_step[j],
                         s5_b_re[j], s5_b_im[j], s5_c_re[j], s5_c_im[j], s5_d[j], s5_w_glu[j],
                         w_out[i], mem_norm[i], w_mem_kv[i], xq_norm[i], xk_norm[i])
        else:
            x = mla_layer(x, mem, cos, sin, ln_gain[i], mla_w_in[j], mla_q_lora_norm[j], mla_kv_lora_norm[j],
                          mla_w_uq[j], mla_w_ukv[j], mla_q_nope_norm[j], mla_k_nope_norm[j],
                          mla_q_rope_norm[j], mla_k_rope_norm[j],
                          w_out[i], mem_norm[i], w_mem_kv[i], xq_norm[i], xk_norm[i])
    return x
```

```cpp
#include <hip/hip_runtime.h>
#include <hip/hip_fp16.h>
#include <hip/hip_cooperative_groups.h>
#include <cstdio>
namespace cg = cooperative_groups;

#ifndef PHMASK
#define PHMASK 0x7ff
#endif
#define PHEN(k) ((PHMASK >> (k)) & 1)
#ifndef MULTI_LAUNCH
#define MULTI_LAUNCH 1
#endif

typedef _Float16 h16;
typedef h16 h16x8 __attribute__((ext_vector_type(8)));
typedef h16 h16x4 __attribute__((ext_vector_type(4)));
typedef float f32x16 __attribute__((ext_vector_type(16)));
#define DI __device__ __forceinline__
#define MFMA32(a, b, c) __builtin_amdgcn_mfma_f32_32x32x16_f16((a), (b), (c), 0, 0, 0)

constexpr int SEQ = 2048, NB = 8, TOK = NB * SEQ, DM = 1024;
constexpr float EPS = 1e-6f;
constexpr float LOG2E = 1.4426950408889634f;

constexpr size_t MiB = (size_t)1 << 20;
constexpr size_t OFF_CTR = 0;
constexpr size_t OFF_S5A = 64 * 1024;
constexpr size_t OFF_S5B = 128 * 1024;
constexpr size_t OFF_S5C = 512 * 1024;
constexpr size_t OFF_S5STEP = 1280 * 1024;
constexpr size_t OFF_KR = 2 * MiB;
constexpr size_t OFF_WOUT1 = 4 * MiB;
constexpr size_t OFF_OBUF = 8 * MiB;
constexpr size_t OFF_WIN0 = 72 * MiB;
constexpr size_t OFF_WGLU = 80 * MiB;
constexpr size_t OFF_WOUT0 = 89 * MiB;
constexpr size_t OFF_WMKV0 = 93 * MiB;
constexpr size_t OFF_WMKV1 = 95 * MiB;
constexpr size_t OFF_MEMK0 = 97 * MiB;
constexpr size_t OFF_MEMVT0 = 99 * MiB;
constexpr size_t OFF_U = 101 * MiB;
constexpr size_t OFF_XQ0 = 149 * MiB;
constexpr size_t OFF_XN0 = 165 * MiB;
constexpr size_t OFF_MEMN0 = 197 * MiB;
constexpr size_t OFF_MEMN1 = 201 * MiB;
constexpr size_t OFF_YG = 165 * MiB;
constexpr size_t OFF_MEMK1 = 250 * MiB;
constexpr size_t OFF_MEMVT1 = 252 * MiB;
constexpr size_t OFF_XN1 = 72 * MiB;
constexpr size_t OFF_WIN1 = 104 * MiB;
constexpr size_t OFF_Q = 72 * MiB;
constexpr size_t OFF_KN = 144 * MiB;
constexpr size_t OFF_VT = 192 * MiB;
constexpr size_t OFF_CQ = 144 * MiB;
constexpr size_t OFF_XQ1 = 160 * MiB;
constexpr size_t OFF_WUQ = 176 * MiB;
constexpr size_t OFF_CKV = 240 * MiB;
constexpr size_t OFF_WUKV = 248 * MiB;

constexpr int LDS_BYTES = 73728 + 1024;
constexpr int LDS_RS = 73728;
constexpr int LDS_ITEM = 73728 + 512;

struct P {
    const float* x; const float* mem; const int* pos;
    const float* ln_gain; const float* w_out; const float* mem_norm; const float* w_mem_kv; const float* xq_norm; const float* xk_norm;
    const float* s5_w_in; const float* lam_re; const float* lam_im; const float* log_step;
    const float* b_re; const float* b_im; const float* c_re; const float* c_im; const float* s5_d; const float* w_glu;
    const float* mla_w_in; const float* q_lora_norm; const float* kv_lora_norm; const float* w_uq; const float* w_ukv;
    const float* q_nope_norm; const float* k_nope_norm; const float* q_rope_norm; const float* k_rope_norm;
    float* out; char* ws;
};

DI float wave_sum(float v) {
    v += __shfl_xor(v, 32); v += __shfl_xor(v, 16); v += __shfl_xor(v, 8);
    v += __shfl_xor(v, 4); v += __shfl_xor(v, 2); v += __shfl_xor(v, 1);
    return v;
}
DI float half_sum(float v) {
    v += __shfl_xor(v, 16); v += __shfl_xor(v, 8); v += __shfl_xor(v, 4); v += __shfl_xor(v, 2); v += __shfl_xor(v, 1);
    return v;
}
DI int crow(int i, int hf) { return (i & 3) + 8 * (i >> 2) + 4 * hf; }
DI int swap23(int m) { return (m & 0x13) | ((m & 4) << 1) | ((m & 8) >> 1); }
DI float sigmoidf_(float x) { return 1.f / (1.f + __expf(-x)); }
DI float siluf_(float x) { return x * sigmoidf_(x); }
DI float geluf_(float x) {
    float z = 0.7978845608028654f * (x + 0.044715f * x * x * x);
    float t = 1.f - 2.f / (1.f + __expf(2.f * z));
    return 0.5f * x * (1.f + t);
}

DI void rmsnorm_rows(const float* __restrict__ src, const float* __restrict__ gain, h16* __restrict__ dst, int nrows,
                     int wgid, int nw, int lane) {
    for (int r = wgid; r < nrows; r += nw) {
        const float4* s4 = (const float4*)(src + (size_t)r * DM);
        float4 v[4]; float ss = 0.f;
#pragma unroll
        for (int i = 0; i < 4; ++i) { v[i] = s4[lane + 64 * i]; ss += v[i].x * v[i].x + v[i].y * v[i].y + v[i].z * v[i].z + v[i].w * v[i].w; }
        ss = wave_sum(ss);
        float rs = rsqrtf(ss * (1.f / DM) + EPS);
#pragma unroll
        for (int i = 0; i < 4; ++i) {
            float4 g = ((const float4*)gain)[lane + 64 * i];
            h16x4 o; o[0] = (h16)(v[i].x * rs * g.x); o[1] = (h16)(v[i].y * rs * g.y); o[2] = (h16)(v[i].z * rs * g.z); o[3] = (h16)(v[i].w * rs * g.w);
            *(h16x4*)(dst + (size_t)r * DM + (lane + 64 * i) * 4) = o;
        }
    }
}

DI void conv_tile(const float* __restrict__ src, int Nsrc, int srccol0, h16* __restrict__ dst, int K, int dstrow0, int k0,
                  const float* __restrict__ kgain, float* tile, int tid) {
    __syncthreads();
    if (srccol0 >= 0) {
#pragma unroll
        for (int i = 0; i < 4; ++i) {
            int k = (tid >> 4) + 16 * i, n = (tid & 15) * 4;
            float4 v = *(const float4*)(src + (size_t)(k0 + k) * Nsrc + srccol0 + n);
            float g = kgain ? kgain[k0 + k] : 1.f;
            tile[k * 65 + n + 0] = v.x * g; tile[k * 65 + n + 1] = v.y * g; tile[k * 65 + n + 2] = v.z * g; tile[k * 65 + n + 3] = v.w * g;
        }
    }
    __syncthreads();
#pragma unroll
    for (int i = 0; i < 2; ++i) {
        int c = tid + 256 * i, n = c >> 3, kc = c & 7;
        h16x8 o;
#pragma unroll
        for (int e = 0; e < 8; ++e) o[e] = (srccol0 >= 0) ? (h16)tile[(kc * 8 + e) * 65 + n] : (h16)0.f;
        *(h16x8*)(dst + (size_t)(dstrow0 + n) * K + k0 + kc * 8) = o;
    }
}

DI void conv_matrix(const P& p, int mat, int bid, int nblk, float* tile, int tid) {
    const float* src; int Nsrc, K, Nd; h16* dst; const float* kg = nullptr;
    switch (mat) {
        case 0: src = p.s5_w_in; Nsrc = 4096; K = 1024; Nd = 4096; dst = (h16*)(p.ws + OFF_WIN0); break;
        case 1: src = p.w_glu; Nsrc = 3072; K = 1536; Nd = 3072; dst = (h16*)(p.ws + OFF_WGLU); break;
        case 2: src = p.w_out; Nsrc = 1024; K = 2048; Nd = 1024; dst = (h16*)(p.ws + OFF_WOUT0); break;
        case 3: src = p.w_out + (size_t)2048 * 1024; Nsrc = 1024; K = 2048; Nd = 1024; dst = (h16*)(p.ws + OFF_WOUT1); break;
        case 4: src = p.w_mem_kv; Nsrc = 1024; K = 1024; Nd = 1024; dst = (h16*)(p.ws + OFF_WMKV0); break;
        case 5: src = p.w_mem_kv + (size_t)1024 * 1024; Nsrc = 1024; K = 1024; Nd = 1024; dst = (h16*)(p.ws + OFF_WMKV1); break;
        case 6: src = p.w_ukv; Nsrc = 3072; K = 256; Nd = 3072; dst = (h16*)(p.ws + OFF_WUKV); kg = p.kv_lora_norm; break;
        case 7: src = p.mla_w_in; Nsrc = 3392; K = 1024; Nd = 3456; dst = (h16*)(p.ws + OFF_WIN1); break;
        default: src = p.w_uq; Nsrc = 2304; K = 512; Nd = 2304; dst = (h16*)(p.ws + OFF_WUQ); kg = p.q_lora_norm; break;
    }
    const int nkt = K / 64, nitems = (Nd / 64) * nkt;
    for (int it = bid; it < nitems; it += nblk) {
        int nt = it / nkt, kt = it % nkt;
        int n0 = nt * 64, sc = n0;
        if (mat == 1) { int t128 = n0 >> 7, half = (n0 >> 6) & 1; sc = (half ? 1536 : 0) + t128 * 64; }
        else if (mat == 7) {
            if (n0 < 768) sc = n0;
            else if (n0 < 1280) sc = 832 + (n0 - 768);
            else if (n0 < 3328) sc = 1344 + (n0 - 1280);
            else if (n0 < 3392) sc = 768 + (n0 - 3328);
            else sc = -1;
        } else if (mat == 8) {
            if (n0 < 1536) { int h = n0 >> 7; sc = h * 192 + (n0 & 127); }
            else { int h = (n0 - 1536) >> 6; sc = h * 192 + 128; }
        }
        conv_tile(src, Nsrc, sc, dst, K, n0, kt * 64, kg, tile, tid);
    }
}

DI void s5_tables(const P& p, int gtid, int nthreads) {
    float* At = (float*)(p.ws + OFF_S5A);
    h16* Bt = (h16*)(p.ws + OFF_S5B);
    h16* Ct = (h16*)(p.ws + OFF_S5C);
    float* St = (float*)(p.ws + OFF_S5STEP);
    for (int idx = gtid; idx < 96 * 64; idx += nthreads) {
        int g = idx >> 6, pp = idx & 63;
        float step = expf(p.log_step[g]);
        float lr = p.lam_re[idx], li = p.lam_im[idx];
        float xr = lr * step, yi = li * step;
        float sy, cy; sincosf(yi, &sy, &cy);
        float ex = expf(xr);
        float are = ex * cy, aim = ex * sy;
        float sh = sinf(0.5f * yi);
        float nre = expm1f(xr) * cy - 2.f * sh * sh;
        float nim = aim;
        float den = (lr * lr + li * li) * step;
        float cre = (nre * lr + nim * li) / den;
        float cim = (nim * lr - nre * li) / den;
        At[idx * 2] = are; At[idx * 2 + 1] = aim;
        if (pp == 0) St[g] = step;
        int q = pp & 31, jj = pp >> 5;
        h16* brow_re = Bt + ((size_t)g * 128 + 32 * jj + q) * 16;
        h16* brow_im = Bt + ((size_t)g * 128 + 32 * (2 + jj) + q) * 16;
        for (int c = 0; c < 16; ++c) {
            float br = p.b_re[(size_t)idx * 16 + c], bi = p.b_im[(size_t)idx * 16 + c];
            brow_re[c] = (h16)(cre * br - cim * bi);
            brow_im[c] = (h16)(cre * bi + cim * br);
        }
        for (int c = 0; c < 16; ++c) {
            float cr = p.c_re[((size_t)g * 16 + c) * 64 + pp], ci = p.c_im[((size_t)g * 16 + c) * 64 + pp];
            Ct[((size_t)g * 32 + c) * 128 + 4 * q + jj] = (h16)cr;
            Ct[((size_t)g * 32 + c) * 128 + 4 * q + 2 + jj] = (h16)(-ci);
            Ct[((size_t)g * 32 + 16 + c) * 128 + 4 * q + jj] = (h16)0.f;
            Ct[((size_t)g * 32 + 16 + c) * 128 + 4 * q + 2 + jj] = (h16)0.f;
        }
    }
}

DI void gemm_tile(const h16* __restrict__ A, int lda, const h16* __restrict__ B, int ldb, int K, char* lds, f32x16 (&acc)[4], int tid) {
    const int lane = tid & 63, wave = __builtin_amdgcn_readfirstlane(tid >> 6), q = lane & 31, hf = lane >> 5;
    const int lr = tid >> 3, lc = tid & 7;
    h16x8 ra[4], rb[4];
#pragma unroll
    for (int j = 0; j < 4; ++j)
#pragma unroll
        for (int i = 0; i < 16; ++i) acc[j][i] = 0.f;
    const int nk = K >> 6;
    const h16* Ap = A + (size_t)lr * lda + lc * 8;
    const h16* Bp = B + (size_t)lr * ldb + lc * 8;
#pragma unroll
    for (int i = 0; i < 4; ++i) { ra[i] = *(const h16x8*)(Ap + (size_t)(32 * i) * lda); rb[i] = *(const h16x8*)(Bp + (size_t)(32 * i) * ldb); }
    __syncthreads();
#pragma unroll
    for (int i = 0; i < 4; ++i) {
        *(h16x8*)(lds + (lr + 32 * i) * 144 + lc * 16) = ra[i];
        *(h16x8*)(lds + 18432 + (lr + 32 * i) * 144 + lc * 16) = rb[i];
    }
    __syncthreads();
    for (int kt = 0; kt < nk; ++kt) {
        if (kt + 1 < nk) {
            const int k0 = (kt + 1) << 6;
#pragma unroll
            for (int i = 0; i < 4; ++i) { ra[i] = *(const h16x8*)(Ap + (size_t)(32 * i) * lda + k0); rb[i] = *(const h16x8*)(Bp + (size_t)(32 * i) * ldb + k0); }
        }
        const char* base = lds + (kt & 1) * 36864;
#pragma unroll
        for (int kk = 0; kk < 4; ++kk) {
            h16x8 af = *(const h16x8*)(base + (wave * 32 + q) * 144 + (kk * 16 + 8 * hf) * 2);
#pragma unroll
            for (int j = 0; j < 4; ++j) {
                h16x8 bf = *(const h16x8*)(base + 18432 + (j * 32 + q) * 144 + (kk * 16 + 8 * hf) * 2);
                acc[j] = MFMA32(af, bf, acc[j]);
            }
        }
        if (kt + 1 < nk) {
            char* nb = lds + ((kt + 1) & 1) * 36864;
#pragma unroll
            for (int i = 0; i < 4; ++i) {
                *(h16x8*)(nb + (lr + 32 * i) * 144 + lc * 16) = ra[i];
                *(h16x8*)(nb + 18432 + (lr + 32 * i) * 144 + lc * 16) = rb[i];
            }
        }
        __syncthreads();
    }
}

DI void row_scales(const h16* __restrict__ A, int K, int m0, char* lds, int tid) {
    __syncthreads();
    const int row = tid >> 1, half = tid & 1, n = K >> 1;
    const h16* ap = A + (size_t)(m0 + row) * K + half * n;
    float ss = 0.f;
    for (int c = 0; c < n; c += 8) {
        h16x8 v = *(const h16x8*)(ap + c);
#pragma unroll
        for (int e = 0; e < 8; ++e) { float f = (float)v[e]; ss += f * f; }
    }
    ss += __shfl_xor(ss, 1);
    if (half == 0) ((float*)(lds + LDS_RS))[row] = rsqrtf(ss / (float)K + EPS);
    __syncthreads();
}

DI void epi_store(const f32x16 (&acc)[4], h16* __restrict__ dst, int ld, int mrow0, int col0, int q, int hf) {
#pragma unroll
    for (int i = 0; i < 16; ++i) {
        h16* rp = dst + (size_t)(mrow0 + crow(i, hf)) * ld + col0 + q;
#pragma unroll
        for (int j = 0; j < 4; ++j) rp[32 * j] = (h16)acc[j][i];
    }
}
DI void epi_norm128(const f32x16 (&acc)[4], const float* __restrict__ gain, const float* rs, int rsrow0, h16* __restrict__ dst, size_t rowstride,
                    int q, int hf) {
    float g[4];
#pragma unroll
    for (int j = 0; j < 4; ++j) g[j] = gain[32 * j + q];
#pragma unroll
    for (int i = 0; i < 16; ++i) {
        const int r = crow(i, hf);
        const float pre = rs ? rs[rsrow0 + r] : 1.f;
        float v[4]; float ss = 0.f;
#pragma unroll
        for (int j = 0; j < 4; ++j) { v[j] = acc[j][i] * pre; ss += v[j] * v[j]; }
        ss = half_sum(ss);
        const float sc = rsqrtf(ss * (1.f / 128.f) + EPS);
        h16* rp = dst + (size_t)r * rowstride + q;
#pragma unroll
        for (int j = 0; j < 4; ++j) rp[32 * j] = (h16)(v[j] * sc * g[j]);
    }
}

template <int DK, bool CAUSAL>
DI void attn_item(const h16* __restrict__ Qb, int qstride, const h16* __restrict__ Kn, int knstride, const h16* __restrict__ Kr,
                  const h16* __restrict__ Vt, int vtstride, int nkt, int q0, h16* __restrict__ outb, int ostride, float sc,
                  char* lds, int tid) {
    constexpr int KSTR = (DK + 8) * 2;
    constexpr int CPK = DK / 8;
    constexpr int NKC = 64 * CPK / 256;
    constexpr int NKS = DK / 16;
    char* Ks = lds; char* Vs = lds + 64 * KSTR;
    const int lane = tid & 63, wave = __builtin_amdgcn_readfirstlane(tid >> 6), q = lane & 31, hf = lane >> 5;
    h16x8 qf[NKS];
#pragma unroll
    for (int ks = 0; ks < NKS; ++ks) qf[ks] = *(const h16x8*)(Qb + (size_t)(wave * 32 + q) * qstride + 16 * ks + 8 * hf);
    h16x8 kreg[NKC], vreg[4];
    f32x16 o[4];
#pragma unroll
    for (int j = 0; j < 4; ++j)
#pragma unroll
        for (int i = 0; i < 16; ++i) o[j][i] = 0.f;
    float m_run = -1e30f, l_run = 0.f;
    const int qw0 = q0 + wave * 32, qglob = qw0 + q;
    const int sq = swap23(q);

    const int tk_off = (tid >> 4) * knstride + (tid & 15) * 8;
    const int tr_off = (tid >> 3) * 64 + (tid & 7) * 8;
    const int tv_off = (tid >> 3) * vtstride + (tid & 7) * 8;
    const int lk_off = (tid >> 4) * KSTR + (tid & 15) * 16;
    const int lr_off = (tid >> 3) * KSTR + 256 + (tid & 7) * 16;
    const int lv_off = (tid >> 3) * 144 + (tid & 7) * 16;
#define ATT_LOAD(kt_)                                                                                                 \
    {                                                                                                                 \
        const h16* knp = Kn + (size_t)((kt_) * 64) * knstride;                                                        \
        _Pragma("unroll") for (int i = 0; i < 4; ++i) kreg[i] = *(const h16x8*)(knp + (16 * i) * knstride + tk_off);  \
        if (DK == 192) {                                                                                              \
            const h16* krp = Kr + (size_t)((kt_) * 64) * 64;                                                          \
            _Pragma("unroll") for (int i = 0; i < NKC - 4; ++i) kreg[4 + i] = *(const h16x8*)(krp + (32 * i) * 64 + tr_off); \
        }                                                                                                             \
        const h16* vp = Vt + (kt_) * 64;                                                                              \
        _Pragma("unroll") for (int i = 0; i < 4; ++i) vreg[i] = *(const h16x8*)(vp + (32 * i) * vtstride + tv_off);   \
    }
    ATT_LOAD(0);
    for (int kt = 0; kt < nkt; ++kt) {
        __syncthreads();
#pragma unroll
        for (int i = 0; i < 4; ++i) *(h16x8*)(Ks + lk_off + (16 * i) * KSTR) = kreg[i];
        if (DK == 192) {
#pragma unroll
            for (int i = 0; i < NKC - 4; ++i) *(h16x8*)(Ks + lr_off + (32 * i) * KSTR) = kreg[4 + i];
        }
#pragma unroll
        for (int i = 0; i < 4; ++i) *(h16x8*)(Vs + lv_off + (32 * i) * 144) = vreg[i];
        __syncthreads();
        if (kt + 1 < nkt) ATT_LOAD(kt + 1);
        const bool skip = CAUSAL && (64 * kt > qw0 + 31);
        if (!skip) {
            f32x16 s0, s1;
#pragma unroll
            for (int i = 0; i < 16; ++i) { s0[i] = 0.f; s1[i] = 0.f; }
#pragma unroll
            for (int ks = 0; ks < NKS; ++ks) {
                h16x8 k0 = *(const h16x8*)(Ks + sq * KSTR + (16 * ks + 8 * hf) * 2);
                h16x8 k1 = *(const h16x8*)(Ks + (32 + sq) * KSTR + (16 * ks + 8 * hf) * 2);
                s0 = MFMA32(k0, qf[ks], s0);
                s1 = MFMA32(k1, qf[ks], s1);
            }
            const bool needmask = CAUSAL && (64 * kt + 63 > qw0);
            float mx = -1e30f;
#pragma unroll
            for (int i = 0; i < 16; ++i) {
                float v0 = s0[i] * sc, v1 = s1[i] * sc;
                if (needmask) {
                    int key = kt * 64 + 16 * (i >> 3) + 8 * hf + (i & 7);
                    if (key > qglob) v0 = -1e30f;
                    if (key + 32 > qglob) v1 = -1e30f;
                }
                s0[i] = v0; s1[i] = v1;
                mx = fmaxf(mx, fmaxf(v0, v1));
            }
            mx = fmaxf(mx, __shfl_xor(mx, 32));
            const float mnew = fmaxf(m_run, mx);
            const float alpha = __builtin_amdgcn_exp2f(m_run - mnew);
            m_run = mnew;
            float rsum = 0.f;
#pragma unroll
            for (int i = 0; i < 16; ++i) {
                float p0 = __builtin_amdgcn_exp2f(s0[i] - mnew), p1 = __builtin_amdgcn_exp2f(s1[i] - mnew);
                s0[i] = p0; s1[i] = p1; rsum += p0 + p1;
            }
            l_run = l_run * alpha + rsum;
#pragma unroll
            for (int j = 0; j < 4; ++j)
#pragma unroll
                for (int i = 0; i < 16; ++i) o[j][i] *= alpha;
#pragma unroll
            for (int t2 = 0; t2 < 4; ++t2) {
                h16x8 pf;
#pragma unroll
                for (int e = 0; e < 8; ++e) pf[e] = (h16)((t2 < 2) ? s0[8 * (t2 & 1) + e] : s1[8 * (t2 & 1) + e]);
#pragma unroll
                for (int j = 0; j < 4; ++j) {
                    h16x8 vf = *(const h16x8*)(Vs + (32 * j + q) * 144 + (16 * t2 + 8 * hf) * 2);
                    o[j] = MFMA32(vf, pf, o[j]);
                }
            }
        }
    }
#undef ATT_LOAD
    const float l = l_run + __shfl_xor(l_run, 32);
    const float inv = 1.f / l;
    h16* orow = outb + (size_t)(wave * 32 + q) * ostride;
#pragma unroll
    for (int j = 0; j < 4; ++j)
#pragma unroll
        for (int g4 = 0; g4 < 4; ++g4) {
            h16* pp = orow + 32 * j + 8 * g4 + 4 * hf;
            h16x4 sg = *(const h16x4*)pp;
            h16x4 ov;
#pragma unroll
            for (int e = 0; e < 4; ++e) ov[e] = (h16)(o[j][4 * g4 + e] * inv * (float)sg[e]);
            *(h16x4*)pp = ov;
        }
}

DI void mem_attn_phase(const P& p, int layer, int* ctr, char* lds, int tid) {
    const h16* xq = (const h16*)(p.ws + (layer ? OFF_XQ1 : OFF_XQ0));
    const h16* mk = (const h16*)(p.ws + (layer ? OFF_MEMK1 : OFF_MEMK0));
    const h16* mvt = (const h16*)(p.ws + (layer ? OFF_MEMVT1 : OFF_MEMVT0));
    h16* obuf = (h16*)(p.ws + OFF_OBUF);
    volatile int* sitem = (volatile int*)(lds + LDS_ITEM);
    const float sc = 0.08838834764831845f * LOG2E;
    for (;;) {
        __syncthreads();
        if (tid == 0) *sitem = atomicAdd(ctr, 1);
        __syncthreads();
        const int it = *sitem;
        if (it >= 512) break;
        const int b = it >> 6, h = (it >> 4) & 3, qt = it & 15;
        const size_t row0 = (size_t)b * SEQ + qt * 128;
        attn_item<128, false>(xq + row0 * 512 + h * 128, 512, mk + (size_t)((b * 4 + h) * 256) * 128, 128, nullptr,
                              mvt + (size_t)((b * 4 + h) * 128) * 256, 256, 4, 0, obuf + row0 * 2048 + 1536 + h * 128, 2048, sc, lds, tid);
    }
}

DI void s5_item(const P& p, int g, int bp, char* ldsw, int lane) {
    const h16* u = (const h16*)(p.ws + OFF_U);
    h16* yg = (h16*)(p.ws + OFF_YG);
    const float* At = (const float*)(p.ws + OFF_S5A);
    const h16* Bt = (const h16*)(p.ws + OFF_S5B);
    const h16* Ct = (const h16*)(p.ws + OFF_S5C);
    const float stp = ((const float*)(p.ws + OFF_S5STEP))[g];
    const int q = lane & 31, hf = lane >> 5;
    h16x8 bfr[4], cfr[8];
#pragma unroll
    for (int j = 0; j < 4; ++j) bfr[j] = *(const h16x8*)(Bt + ((size_t)g * 128 + 32 * j + q) * 16 + 8 * hf);
#pragma unroll
    for (int ks = 0; ks < 8; ++ks) cfr[ks] = *(const h16x8*)(Ct + ((size_t)g * 32 + q) * 128 + 16 * ks + 8 * hf);
    const float are0 = At[(g * 64 + q) * 2], aim0 = At[(g * 64 + q) * 2 + 1];
    const float are1 = At[(g * 64 + q + 32) * 2], aim1 = At[(g * 64 + q + 32) * 2 + 1];
    const float dq = (q < 16) ? p.s5_d[g * 16 + q] : 0.f;
    float hr0 = 0.f, hi0 = 0.f, hr1 = 0.f, hi1 = 0.f;
    const int aseq = (q >> 2) & 1, att = (q & 3) + 4 * (q >> 3);
    const h16* ua = u + ((size_t)(2 * bp + aseq) * SEQ + att) * 1536 + g * 16 + 8 * hf;
    const size_t eoff = ((size_t)(2 * bp + hf) * SEQ) * 1536 + g * 16 + (q & 15);
    const h16* ue = u + eoff;
    h16* ye = yg + eoff;
    for (int t0 = 0; t0 < SEQ; t0 += 16) {
        h16x8 af = *(const h16x8*)(ua + (size_t)t0 * 1536);
        f32x16 z;
#pragma unroll
        for (int i = 0; i < 16; ++i) z[i] = 0.f;
        f32x16 a0 = MFMA32(af, bfr[0], z), a1 = MFMA32(af, bfr[1], z), a2 = MFMA32(af, bfr[2], z), a3 = MFMA32(af, bfr[3], z);
#pragma unroll
        for (int i = 0; i < 16; ++i) {
            float nr0 = fmaf(are0, hr0, fmaf(-aim0, hi0, a0[i]));
            float ni0 = fmaf(are0, hi0, fmaf(aim0, hr0, a2[i]));
            float nr1 = fmaf(are1, hr1, fmaf(-aim1, hi1, a1[i]));
            float ni1 = fmaf(are1, hi1, fmaf(aim1, hr1, a3[i]));
            hr0 = nr0; hi0 = ni0; hr1 = nr1; hi1 = ni1;
            h16x4 hv; hv[0] = (h16)(hr0 * stp); hv[1] = (h16)(hr1 * stp); hv[2] = (h16)(hi0 * stp); hv[3] = (h16)(hi1 * stp);
            *(h16x4*)(ldsw + crow(i, hf) * 272 + q * 8) = hv;
        }
        __builtin_amdgcn_fence(__ATOMIC_RELEASE, "workgroup");
        __builtin_amdgcn_wave_barrier();
        __builtin_amdgcn_fence(__ATOMIC_ACQUIRE, "workgroup");
        f32x16 y = z;
#pragma unroll
        for (int ks = 0; ks < 8; ++ks) {
            h16x8 hfr = *(const h16x8*)(ldsw + q * 272 + (16 * ks + 8 * hf) * 2);
            y = MFMA32(hfr, cfr[ks], y);
        }
        __builtin_amdgcn_fence(__ATOMIC_RELEASE, "workgroup");
        __builtin_amdgcn_wave_barrier();
        __builtin_amdgcn_fence(__ATOMIC_ACQUIRE, "workgroup");
        if (q < 16) {
#pragma unroll
            for (int i = 0; i < 16; ++i) {
                float uu = (float)ue[(size_t)(t0 + i) * 1536];
                float v = y[i] + dq * uu;
                ye[(size_t)(t0 + i) * 1536] = (h16)geluf_(v);
            }
        }
    }
}

__global__ void __launch_bounds__(256, 2) mega(P p, int lo, int hi) {
    __shared__ __attribute__((aligned(16))) char lds[LDS_BYTES];
    cg::grid_group grid = cg::this_grid();
    const int tid = threadIdx.x, lane = tid & 63, wave = tid >> 6, q = lane & 31, hf = lane >> 5;
    const int bid = blockIdx.x, nblk = gridDim.x;
    int* ctr = (int*)(p.ws + OFF_CTR);
    h16* obuf = (h16*)(p.ws + OFF_OBUF);
    const float* rs = (const float*)(lds + LDS_RS);

#define RUN(k) (lo <= (k) && (k) < hi)
#define SYNC(k) if (RUN(k) && RUN((k) + 1)) grid.sync();
    if (RUN(0) && PHEN(0)) {
            for (int m = 0; m < 7; ++m) conv_matrix(p, m, bid, nblk, (float*)lds, tid);
            rmsnorm_rows(p.x, p.ln_gain, (h16*)(p.ws + OFF_XN0), TOK, bid * 4 + wave, nblk * 4, lane);
            rmsnorm_rows(p.mem, p.mem_norm, (h16*)(p.ws + OFF_MEMN0), 2048, bid * 4 + wave, nblk * 4, lane);
            rmsnorm_rows(p.mem, p.mem_norm + DM, (h16*)(p.ws + OFF_MEMN1), 2048, bid * 4 + wave, nblk * 4, lane);
            s5_tables(p, bid * 256 + tid, nblk * 256);
    }
    SYNC(0)
    if (RUN(1) && PHEN(1)) {
            const h16* xn = (const h16*)(p.ws + OFF_XN0);
            const h16* w = (const h16*)(p.ws + OFF_WIN0);
            for (int t = bid; t < 4096 + 256; t += nblk) {
                f32x16 acc[4];
                if (t < 4096) {
                    const int mt = t >> 5, nt = t & 31, m0 = mt * 128, n0 = nt * 128;
                    gemm_tile(xn + (size_t)m0 * DM, DM, w + (size_t)n0 * DM, DM, DM, lds, acc, tid);
                    const int mr = m0 + wave * 32;
                    if (n0 < 1536) epi_store(acc, (h16*)(p.ws + OFF_U), 1536, mr, n0, q, hf);
                    else if (n0 < 2048)
                        epi_norm128(acc, p.xq_norm, nullptr, 0, (h16*)(p.ws + OFF_XQ0) + (size_t)mr * 512 + (n0 - 1536), 512, q, hf);
                    else {
#pragma unroll
                        for (int i = 0; i < 16; ++i) {
                            h16* rp = obuf + (size_t)(mr + crow(i, hf)) * 2048 + (n0 - 2048) + q;
#pragma unroll
                            for (int j = 0; j < 4; ++j) rp[32 * j] = (h16)siluf_(acc[j][i]);
                        }
                    }
                } else {
                    const int t2 = t - 4096, layer = t2 >> 7, mt = (t2 >> 3) & 15, nt = t2 & 7;
                    const h16* mn = (const h16*)(p.ws + (layer ? OFF_MEMN1 : OFF_MEMN0));
                    const h16* wm = (const h16*)(p.ws + (layer ? OFF_WMKV1 : OFF_WMKV0));
                    const int m0 = mt * 128, b = m0 >> 8, key0 = m0 & 255;
                    if (nt < 4) {
                        gemm_tile(mn + (size_t)m0 * DM, DM, wm + (size_t)(nt * 128) * DM, DM, DM, lds, acc, tid);
                        h16* mk = (h16*)(p.ws + (layer ? OFF_MEMK1 : OFF_MEMK0));
                        epi_norm128(acc, p.xk_norm + layer * 128, nullptr, 0, mk + (size_t)((b * 4 + nt) * 256 + key0 + wave * 32) * 128, 128, q, hf);
                    } else {
                        const int h = nt - 4;
                        gemm_tile(wm + (size_t)(512 + h * 128) * DM, DM, mn + (size_t)m0 * DM, DM, DM, lds, acc, tid);
                        h16* mvt = (h16*)(p.ws + (layer ? OFF_MEMVT1 : OFF_MEMVT0));
                        epi_store(acc, mvt + (size_t)((b * 4 + h) * 128) * 256, 256, wave * 32, key0, q, hf);
                    }
                }
            }
    }
    SYNC(1)
    if (RUN(2) && PHEN(2)) {
            const int wi = wave * nblk + bid;
            for (int it = wi; it < 384; it += 4 * nblk) s5_item(p, it >> 2, it & 3, lds + wave * 8704, lane);
            mem_attn_phase(p, 0, ctr + 0, lds, tid);
    }
    SYNC(2)
    if (RUN(3) && PHEN(3)) {
            const h16* ygp = (const h16*)(p.ws + OFF_YG);
            const h16* w = (const h16*)(p.ws + OFF_WGLU);
            for (int t = bid; t < 128 * 24; t += nblk) {
                const int mt = t / 24, nt = t % 24, m0 = mt * 128;
                f32x16 acc[4];
                gemm_tile(ygp + (size_t)m0 * 1536, 1536, w + (size_t)(nt * 128) * 1536, 1536, 1536, lds, acc, tid);
                const int mr = m0 + wave * 32;
#pragma unroll
                for (int i = 0; i < 16; ++i) {
                    h16* rp = obuf + (size_t)(mr + crow(i, hf)) * 2048 + nt * 64 + q;
#pragma unroll
                    for (int j = 0; j < 2; ++j) {
                        float v = acc[j][i] * sigmoidf_(acc[j + 2][i]);
                        rp[32 * j] = (h16)(v * (float)rp[32 * j]);
                    }
                }
            }
    }
    SYNC(3)
    if (RUN(4) && PHEN(4)) {
            const h16* w = (const h16*)(p.ws + (4 == 4 ? OFF_WOUT0 : OFF_WOUT1));
            const float* xin = (4 == 4) ? p.x : p.out;
            for (int t = bid; t < 128 * 8; t += nblk) {
                const int mt = t >> 3, nt = t & 7, m0 = mt * 128, n0 = nt * 128;
                f32x16 acc[4];
                gemm_tile(obuf + (size_t)m0 * 2048, 2048, w + (size_t)n0 * 2048, 2048, 2048, lds, acc, tid);
                const int mr = m0 + wave * 32;
#pragma unroll
                for (int i = 0; i < 16; ++i) {
                    const size_t o = (size_t)(mr + crow(i, hf)) * DM + n0 + q;
#pragma unroll
                    for (int j = 0; j < 4; ++j) p.out[o + 32 * j] = xin[o + 32 * j] + acc[j][i];
                }
            }
    }
    SYNC(4)
    if (RUN(5) && PHEN(5)) {
            rmsnorm_rows(p.out, p.ln_gain + DM, (h16*)(p.ws + OFF_XN1), TOK, bid * 4 + wave, nblk * 4, lane);
            conv_matrix(p, 7, bid, nblk, (float*)lds, tid);
            conv_matrix(p, 8, bid, nblk, (float*)lds, tid);
    }
    SYNC(5)
    if (RUN(6) && PHEN(6)) {
            const h16* xn = (const h16*)(p.ws + OFF_XN1);
            const h16* w = (const h16*)(p.ws + OFF_WIN1);
            for (int t = bid; t < 128 * 27; t += nblk) {
                const int mt = t / 27, nt = t % 27, m0 = mt * 128, n0 = nt * 128;
                f32x16 acc[4];
                gemm_tile(xn + (size_t)m0 * DM, DM, w + (size_t)n0 * DM, DM, DM, lds, acc, tid);
                const int mr = m0 + wave * 32;
                if (nt < 4) epi_store(acc, (h16*)(p.ws + OFF_CQ), 512, mr, n0, q, hf);
                else if (nt < 6) epi_store(acc, (h16*)(p.ws + OFF_CKV), 256, mr, n0 - 512, q, hf);
                else if (nt < 10)
                    epi_norm128(acc, p.xq_norm + 128, nullptr, 0, (h16*)(p.ws + OFF_XQ1) + (size_t)mr * 512 + (n0 - 768), 512, q, hf);
                else if (nt < 26) {
#pragma unroll
                    for (int i = 0; i < 16; ++i) {
                        h16* rp = obuf + (size_t)(mr + crow(i, hf)) * 2048 + (n0 - 1280) + q;
#pragma unroll
                        for (int j = 0; j < 4; ++j) rp[32 * j] = (h16)siluf_(acc[j][i]);
                    }
                } else {
                    h16* kr = (h16*)(p.ws + OFF_KR);
                    const float invf = powf(10000.f, -(float)q * (1.f / 32.f));
                    const float g0 = p.k_rope_norm[q], g1 = p.k_rope_norm[32 + q];
#pragma unroll
                    for (int i = 0; i < 16; ++i) {
                        const int row = mr + crow(i, hf);
                        float v0 = acc[0][i], v1 = acc[1][i];
                        float ss = half_sum(v0 * v0 + v1 * v1);
                        float sc = rsqrtf(ss * (1.f / 64.f) + EPS);
                        float x1 = v0 * sc * g0, x2 = v1 * sc * g1;
                        float sn, cs; sincosf((float)p.pos[row] * invf, &sn, &cs);
                        kr[(size_t)row * 64 + q] = (h16)(x1 * cs - x2 * sn);
                        kr[(size_t)row * 64 + 32 + q] = (h16)(x1 * sn + x2 * cs);
                    }
                }
            }
    }
    SYNC(6)
    if (RUN(7) && PHEN(7)) {
            const h16* cq = (const h16*)(p.ws + OFF_CQ);
            const h16* w = (const h16*)(p.ws + OFF_WUQ);
            h16* Q = (h16*)(p.ws + OFF_Q);
            for (int t = bid; t < 128 * 18; t += nblk) {
                const int mt = t / 18, nt = t % 18, m0 = mt * 128;
                f32x16 acc[4];
                row_scales(cq, 512, m0, lds, tid);
                gemm_tile(cq + (size_t)m0 * 512, 512, w + (size_t)(nt * 128) * 512, 512, 512, lds, acc, tid);
                const int b = m0 >> 11, l0 = (m0 & 2047) + wave * 32;
                if (nt < 12) {
                    epi_norm128(acc, p.q_nope_norm, rs, wave * 32, Q + ((size_t)(b * 12 + nt) * SEQ + l0) * 192, 192, q, hf);
                } else {
                    const int hA = 2 * (nt - 12);
                    const float invf = powf(10000.f, -(float)q * (1.f / 32.f));
                    const float g0 = p.q_rope_norm[q], g1 = p.q_rope_norm[32 + q];
#pragma unroll
                    for (int i = 0; i < 16; ++i) {
                        const int r = crow(i, hf);
                        const float pre = rs[wave * 32 + r];
                        float sn, cs; sincosf((float)p.pos[m0 + wave * 32 + r] * invf, &sn, &cs);
#pragma unroll
                        for (int hh = 0; hh < 2; ++hh) {
                            float v0 = acc[2 * hh][i] * pre, v1 = acc[2 * hh + 1][i] * pre;
                            float ss = half_sum(v0 * v0 + v1 * v1);
                            float sc = rsqrtf(ss * (1.f / 64.f) + EPS);
                            float x1 = v0 * sc * g0, x2 = v1 * sc * g1;
                            h16* qp = Q + ((size_t)(b * 12 + hA + hh) * SEQ + l0 + r) * 192 + 128 + q;
                            qp[0] = (h16)(x1 * cs - x2 * sn);
                            qp[32] = (h16)(x1 * sn + x2 * cs);
                        }
                    }
                }
            }
            mem_attn_phase(p, 1, ctr + 1, lds, tid);
    }
    SYNC(7)
    if (RUN(8) && PHEN(8)) {
            const h16* ckv = (const h16*)(p.ws + OFF_CKV);
            const h16* w = (const h16*)(p.ws + OFF_WUKV);
            for (int t = bid; t < 128 * 24; t += nblk) {
                const int mt = t / 24, nt = t % 24, m0 = mt * 128, h = nt >> 1;
                f32x16 acc[4];
                row_scales(ckv, 256, m0, lds, tid);
                const int b = m0 >> 11, l0 = m0 & 2047;
                if ((nt & 1) == 0) {
                    gemm_tile(ckv + (size_t)m0 * 256, 256, w + (size_t)(h * 256) * 256, 256, 256, lds, acc, tid);
                    h16* Kn = (h16*)(p.ws + OFF_KN);
                    epi_norm128(acc, p.k_nope_norm, rs, wave * 32, Kn + ((size_t)(b * 12 + h) * SEQ + l0 + wave * 32) * 128, 128, q, hf);
                } else {
                    gemm_tile(w + (size_t)(h * 256 + 128) * 256, 256, ckv + (size_t)m0 * 256, 256, 256, lds, acc, tid);
                    h16* Vt = (h16*)(p.ws + OFF_VT) + (size_t)((b * 12 + h) * 128) * SEQ;
                    float pre[4];
#pragma unroll
                    for (int j = 0; j < 4; ++j) pre[j] = rs[32 * j + q];
#pragma unroll
                    for (int i = 0; i < 16; ++i) {
                        h16* rp = Vt + (size_t)(wave * 32 + crow(i, hf)) * SEQ + l0 + q;
#pragma unroll
                        for (int j = 0; j < 4; ++j) rp[32 * j] = (h16)(acc[j][i] * pre[j]);
                    }
                }
            }
    }
    SYNC(8)
    if (RUN(9) && PHEN(9)) {
            const h16* Q = (const h16*)(p.ws + OFF_Q);
            const h16* Kn = (const h16*)(p.ws + OFF_KN);
            const h16* Kr = (const h16*)(p.ws + OFF_KR);
            const h16* Vt = (const h16*)(p.ws + OFF_VT);
            volatile int* sitem = (volatile int*)(lds + LDS_ITEM);
            const float sc = 0.07216878364870322f * LOG2E;
            for (;;) {
                __syncthreads();
                if (tid == 0) *sitem = atomicAdd(ctr + 2, 1);
                __syncthreads();
                const int it = *sitem;
                if (it >= 1536) break;
                const int qt = 15 - it / 96, bh = it % 96, b = bh / 12, h = bh % 12;
                attn_item<192, true>(Q + ((size_t)bh * SEQ + qt * 128) * 192, 192, Kn + (size_t)bh * SEQ * 128, 128, Kr + (size_t)b * SEQ * 64,
                                     Vt + (size_t)bh * 128 * SEQ, SEQ, 2 * qt + 2, qt * 128,
                                     obuf + ((size_t)b * SEQ + qt * 128) * 2048 + h * 128, 2048, sc, lds, tid);
            }
    }
    SYNC(9)
    if (RUN(10) && PHEN(4)) {
            const h16* w = (const h16*)(p.ws + (10 == 4 ? OFF_WOUT0 : OFF_WOUT1));
            const float* xin = (10 == 4) ? p.x : p.out;
            for (int t = bid; t < 128 * 8; t += nblk) {
                const int mt = t >> 3, nt = t & 7, m0 = mt * 128, n0 = nt * 128;
                f32x16 acc[4];
                gemm_tile(obuf + (size_t)m0 * 2048, 2048, w + (size_t)n0 * 2048, 2048, 2048, lds, acc, tid);
                const int mr = m0 + wave * 32;
#pragma unroll
                for (int i = 0; i < 16; ++i) {
                    const size_t o = (size_t)(mr + crow(i, hf)) * DM + n0 + q;
#pragma unroll
                    for (int j = 0; j < 4; ++j) p.out[o + 32 * j] = xin[o + 32 * j] + acc[j][i];
                }
            }
    }
}

extern "C" void kernel_launch(void* const* d_in, const int* in_sizes, int n_in, void* d_out, int out_size, void* d_ws, size_t ws_size,
                              hipStream_t stream) {
    static int grid = 0;
    if (!grid) {
        int dev = 0, cus = 0, per_cu = 0;
        hipGetDevice(&dev);
        hipDeviceGetAttribute(&cus, hipDeviceAttributeMultiprocessorCount, dev);
        hipOccupancyMaxActiveBlocksPerMultiprocessor(&per_cu, mega, 256, 0);
        if (per_cu < 1) per_cu = 1;
        if (per_cu > 2) per_cu = 2;
        grid = cus * per_cu;
    }
    P p{};
    p.x = (const float*)d_in[0]; p.mem = (const float*)d_in[1]; p.pos = (const int*)d_in[2];
    p.ln_gain = (const float*)d_in[3]; p.w_out = (const float*)d_in[4]; p.mem_norm = (const float*)d_in[5];
    p.w_mem_kv = (const float*)d_in[6]; p.xq_norm = (const float*)d_in[7]; p.xk_norm = (const float*)d_in[8];
    p.s5_w_in = (const float*)d_in[9]; p.lam_re = (const float*)d_in[10]; p.lam_im = (const float*)d_in[11];
    p.log_step = (const float*)d_in[12]; p.b_re = (const float*)d_in[13]; p.b_im = (const float*)d_in[14];
    p.c_re = (const float*)d_in[15]; p.c_im = (const float*)d_in[16]; p.s5_d = (const float*)d_in[17]; p.w_glu = (const float*)d_in[18];
    p.mla_w_in = (const float*)d_in[19]; p.q_lora_norm = (const float*)d_in[20]; p.kv_lora_norm = (const float*)d_in[21];
    p.w_uq = (const float*)d_in[22]; p.w_ukv = (const float*)d_in[23]; p.q_nope_norm = (const float*)d_in[24];
    p.k_nope_norm = (const float*)d_in[25]; p.q_rope_norm = (const float*)d_in[26]; p.k_rope_norm = (const float*)d_in[27];
    p.out = (float*)d_out; p.ws = (char*)d_ws;
    hipMemsetAsync(d_ws, 0, 4096, stream);
#if MULTI_LAUNCH
    for (int ph = 0; ph < 11; ++ph) hipLaunchKernelGGL(mega, dim3(grid), dim3(256), 0, stream, p, ph, ph + 1);
#else
    int lo = 0, hi = 11;
    void* args[] = {&p, &lo, &hi};
    hipError_t e = hipLaunchCooperativeKernel((void*)mega, dim3(grid), dim3(256), args, 0, stream);
    if (e != hipSuccess) fprintf(stderr, "cooperative launch failed: %s (grid %d)\n", hipGetErrorString(e), grid);
#endif
}
```

```cpp
#include <hip/hip_runtime.h>
#include <hip/hip_fp16.h>
#include <hip/hip_cooperative_groups.h>
#include <cstdio>
namespace cg = cooperative_groups;

#ifndef PHMASK
#define PHMASK 0x7ff
#endif
#define PHEN(k) ((PHMASK >> (k)) & 1)
#ifndef DUPMASK
#define DUPMASK 0
#endif
#define NREP(k) (((DUPMASK >> (k)) & 1) ? 2 : 1)
#ifndef MULTI_LAUNCH
#define MULTI_LAUNCH 0
#endif

typedef _Float16 h16;
typedef h16 h16x8 __attribute__((ext_vector_type(8)));
typedef h16 h16x4 __attribute__((ext_vector_type(4)));
typedef float f32x16 __attribute__((ext_vector_type(16)));
typedef float f32x4 __attribute__((ext_vector_type(4)));
__device__ __forceinline__ float4 nt_load4(const float* p) { const f32x4 v = __builtin_nontemporal_load((const f32x4*)p); return make_float4(v[0], v[1], v[2], v[3]); }
#define MFMA16(a, b, c) __builtin_amdgcn_mfma_f32_16x16x32_f16((a), (b), (c), 0, 0, 0)
#define DI __device__ __forceinline__
#define MFMA32(a, b, c) __builtin_amdgcn_mfma_f32_32x32x16_f16((a), (b), (c), 0, 0, 0)

constexpr int SEQ = 2048, NB = 8, TOK = NB * SEQ, DM = 1024;
constexpr float EPS = 1e-6f;
constexpr float LOG2E = 1.4426950408889634f;

constexpr size_t MiB = (size_t)1 << 20;
constexpr size_t OFF_CTR = 0;
constexpr size_t OFF_BAR = 16 * 1024;
constexpr size_t OFF_S5A = 64 * 1024;
constexpr size_t OFF_S5B = 128 * 1024;
constexpr size_t OFF_S5C = 512 * 1024;
constexpr size_t OFF_S5STEP = 1280 * 1024;
constexpr size_t OFF_ROWSS2 = 1472 * 1024;
constexpr size_t OFF_ROWSS3 = 1536 * 1024;
constexpr size_t OFF_ROWSS = 1408 * 1024;
constexpr size_t OFF_S5A128 = 1344 * 1024;
constexpr size_t OFF_S5E = 214 * ((size_t)1 << 20);
constexpr size_t OFF_KR = 2 * MiB;
constexpr size_t OFF_WOUT1 = 4 * MiB;
constexpr size_t OFF_OBUF = 8 * MiB;
constexpr size_t OFF_WIN0 = 72 * MiB;
constexpr size_t OFF_WGLU = 80 * MiB;
constexpr size_t OFF_WOUT0 = 89 * MiB;
constexpr size_t OFF_WMKV0 = 93 * MiB;
constexpr size_t OFF_WMKV1 = 95 * MiB;
constexpr size_t OFF_MEMK0 = 97 * MiB;
constexpr size_t OFF_MEMVT0 = 99 * MiB;
constexpr size_t OFF_U = 101 * MiB;
constexpr size_t OFF_XQ0 = 149 * MiB;
constexpr size_t OFF_XN0 = 165 * MiB;
constexpr size_t OFF_MEMN0 = 197 * MiB;
constexpr size_t OFF_MEMN1 = 201 * MiB;
constexpr size_t OFF_YG = 165 * MiB;
constexpr size_t OFF_MEMK1 = 250 * MiB;
constexpr size_t OFF_MEMVT1 = 252 * MiB;
constexpr size_t OFF_XN1 = 112 * MiB;
constexpr size_t OFF_WIN1 = 104 * MiB;
constexpr size_t OFF_Q = 72 * MiB;
constexpr size_t OFF_KN = 144 * MiB;
constexpr size_t OFF_VT = 192 * MiB;
constexpr size_t OFF_CQ = 144 * MiB;
constexpr size_t OFF_XQ1 = 160 * MiB;
constexpr size_t OFF_WUQ = 176 * MiB;
constexpr size_t OFF_CKV = 240 * MiB;
constexpr size_t OFF_WUKV = 248 * MiB;

constexpr int LDS_BYTES = 73728 + 1024;
constexpr int LDS_XB = 73728 + 768;
constexpr int LDS_RS = 73728;
constexpr int LDS_ITEM = 73728 + 512;

struct P {
    const float* x; const float* mem; const int* pos;
    const float* ln_gain; const float* w_out; const float* mem_norm; const float* w_mem_kv; const float* xq_norm; const float* xk_norm;
    const float* s5_w_in; const float* lam_re; const float* lam_im; const float* log_step;
    const float* b_re; const float* b_im; const float* c_re; const float* c_im; const float* s5_d; const float* w_glu;
    const float* mla_w_in; const float* q_lora_norm; const float* kv_lora_norm; const float* w_uq; const float* w_ukv;
    const float* q_nope_norm; const float* k_nope_norm; const float* q_rope_norm; const float* k_rope_norm;
    float* out; char* ws;
};

DI float wave_sum(float v) {
    v += __shfl_xor(v, 32); v += __shfl_xor(v, 16); v += __shfl_xor(v, 8);
    v += __shfl_xor(v, 4); v += __shfl_xor(v, 2); v += __shfl_xor(v, 1);
    return v;
}
DI float half_sum(float v) {
    v += __shfl_xor(v, 16); v += __shfl_xor(v, 8); v += __shfl_xor(v, 4); v += __shfl_xor(v, 2); v += __shfl_xor(v, 1);
    return v;
}
DI int crow(int i, int hf) { return (i & 3) + 8 * (i >> 2) + 4 * hf; }
DI int swap23(int m) { return (m & 0x13) | ((m & 4) << 1) | ((m & 8) >> 1); }
DI float sigmoidf_(float x) { return __builtin_amdgcn_rcpf(1.f + __expf(-x)); }
DI float siluf_(float x) { return x * sigmoidf_(x); }
DI float geluf_(float x) {
    const float z2 = 1.5957691216057308f * x * fmaf(0.044715f * x, x, 1.f);
    return x * __builtin_amdgcn_rcpf(1.f + __expf(-z2));
}

DI void rmsnorm_rows(const float* __restrict__ src, const float* __restrict__ gain, h16* __restrict__ dst, int nrows,
                     int wgid, int nw, int lane) {
    float4 v[4], vn[4];
    int r = wgid;
    if (r < nrows) {
#pragma unroll
        for (int i = 0; i < 4; ++i) v[i] = nt_load4(src + (size_t)r * DM + (lane + 64 * i) * 4);
    }
    for (; r < nrows; r += nw) {
        const int rn = r + nw;
        if (rn < nrows) {
#pragma unroll
            for (int i = 0; i < 4; ++i) vn[i] = nt_load4(src + (size_t)rn * DM + (lane + 64 * i) * 4);
        }
        float ss = 0.f;
#pragma unroll
        for (int i = 0; i < 4; ++i) ss += v[i].x * v[i].x + v[i].y * v[i].y + v[i].z * v[i].z + v[i].w * v[i].w;
        ss = wave_sum(ss);
        float rs = rsqrtf(ss * (1.f / DM) + EPS);
#pragma unroll
        for (int i = 0; i < 4; ++i) {
            float4 g = ((const float4*)gain)[lane + 64 * i];
            h16x4 o; o[0] = (h16)(v[i].x * rs * g.x); o[1] = (h16)(v[i].y * rs * g.y); o[2] = (h16)(v[i].z * rs * g.z); o[3] = (h16)(v[i].w * rs * g.w);
            *(h16x4*)(dst + (size_t)r * DM + (lane + 64 * i) * 4) = o;
        }
#pragma unroll
        for (int i = 0; i < 4; ++i) v[i] = vn[i];
    }
}

DI void conv_tile(const float* __restrict__ src, int Nsrc, int srccol0, h16* __restrict__ dst, int K, int dstrow0, int k0,
                  const float* __restrict__ kgain, float* tile, int tid) {
    __syncthreads();
    if (srccol0 >= 0) {
#pragma unroll
        for (int i = 0; i < 4; ++i) {
            int k = (tid >> 4) + 16 * i, n = (tid & 15) * 4;
            float4 v = nt_load4(src + (size_t)(k0 + k) * Nsrc + srccol0 + n);
            float g = kgain ? kgain[k0 + k] : 1.f;
            tile[k * 65 + n + 0] = v.x * g; tile[k * 65 + n + 1] = v.y * g; tile[k * 65 + n + 2] = v.z * g; tile[k * 65 + n + 3] = v.w * g;
        }
    }
    __syncthreads();
#pragma unroll
    for (int i = 0; i < 2; ++i) {
        int c = tid + 256 * i, n = c >> 3, kc = c & 7;
        h16x8 o;
#pragma unroll
        for (int e = 0; e < 8; ++e) o[e] = (srccol0 >= 0) ? (h16)tile[(kc * 8 + e) * 65 + n] : (h16)0.f;
        *(h16x8*)(dst + (size_t)(dstrow0 + n) * K + k0 + kc * 8) = o;
    }
}

DI int conv_matrix(const P& p, int mat, int bid, int nblk, float* tile, int tid, int rot = 0) {
    const float* src; int Nsrc, K, Nd; h16* dst; const float* kg = nullptr;
    switch (mat) {
        case 0: src = p.s5_w_in; Nsrc = 4096; K = 1024; Nd = 4096; dst = (h16*)(p.ws + OFF_WIN0); break;
        case 1: src = p.w_glu; Nsrc = 3072; K = 1536; Nd = 3072; dst = (h16*)(p.ws + OFF_WGLU); break;
        case 2: src = p.w_out; Nsrc = 1024; K = 2048; Nd = 1024; dst = (h16*)(p.ws + OFF_WOUT0); break;
        case 3: src = p.w_out + (size_t)2048 * 1024; Nsrc = 1024; K = 2048; Nd = 1024; dst = (h16*)(p.ws + OFF_WOUT1); break;
        case 4: src = p.w_mem_kv; Nsrc = 1024; K = 1024; Nd = 1024; dst = (h16*)(p.ws + OFF_WMKV0); break;
        case 5: src = p.w_mem_kv + (size_t)1024 * 1024; Nsrc = 1024; K = 1024; Nd = 1024; dst = (h16*)(p.ws + OFF_WMKV1); break;
        case 6: src = p.w_ukv; Nsrc = 3072; K = 256; Nd = 3072; dst = (h16*)(p.ws + OFF_WUKV); kg = p.kv_lora_norm; break;
        case 7: src = p.mla_w_in; Nsrc = 3392; K = 1024; Nd = 3456; dst = (h16*)(p.ws + OFF_WIN1); kg = p.ln_gain + DM; break;
        default: src = p.w_uq; Nsrc = 2304; K = 512; Nd = 2304; dst = (h16*)(p.ws + OFF_WUQ); kg = p.q_lora_norm; break;
    }
    const int nkt = K / 64, nitems = (Nd / 64) * nkt;
    for (int it = (bid + nblk - rot % nblk) % nblk; it < nitems; it += nblk) {
        int nt = it / nkt, kt = it % nkt;
        int n0 = nt * 64, sc = n0;
        if (mat == 1) { int t128 = n0 >> 7, half = (n0 >> 6) & 1; sc = (half ? 1536 : 0) + t128 * 64; }
        else if (mat == 7) {
            if (n0 < 768) sc = n0;
            else if (n0 < 1280) sc = 832 + (n0 - 768);
            else if (n0 < 3328) sc = 1344 + (n0 - 1280);
            else if (n0 < 3392) sc = 768 + (n0 - 3328);
            else sc = -1;
        } else if (mat == 8) {
            if (n0 < 1536) { int h = n0 >> 7; sc = h * 192 + (n0 & 127); }
            else { int h = (n0 - 1536) >> 6; sc = h * 192 + 128; }
        }
        conv_tile(src, Nsrc, sc, dst, K, n0, kt * 64, kg, tile, tid);
    }
    return nitems;
}

DI void s5_tables(const P& p, int gtid, int nthreads) {
    float* At = (float*)(p.ws + OFF_S5A);
    h16* Bt = (h16*)(p.ws + OFF_S5B);
    h16* Ct = (h16*)(p.ws + OFF_S5C);
    float* St = (float*)(p.ws + OFF_S5STEP);
    for (int idx2 = gtid; idx2 < 96 * 64 * 16; idx2 += nthreads) {
        const int idx = idx2 >> 4, c = idx2 & 15;
        const int g = idx >> 6, pp = idx & 63;
        const float step = expf(p.log_step[g]);
        const float lr = p.lam_re[idx], li = p.lam_im[idx];
        const float xr = lr * step, yi = li * step;
        float sy, cy; sincosf(yi, &sy, &cy);
        const float ex = expf(xr);
        const float are = ex * cy, aim = ex * sy;
        const float sh = sinf(0.5f * yi);
        const float nre = expm1f(xr) * cy - 2.f * sh * sh;
        const float nim = aim;
        const float den = (lr * lr + li * li) * step;
        const float cre = (nre * lr + nim * li) / den;
        const float cim = (nim * lr - nre * li) / den;
        if (c == 0) {
            At[idx * 2] = are; At[idx * 2 + 1] = aim;
            float s128, c128; sincosf(128.f * yi, &s128, &c128);
            const float e128 = expf(128.f * xr);
            float* A128 = (float*)(p.ws + OFF_S5A128);
            A128[idx * 2] = e128 * c128; A128[idx * 2 + 1] = e128 * s128;
            if (pp == 0) St[g] = step;
        }
        const int q = pp & 31, jj = pp >> 5;
        const float br = p.b_re[(size_t)idx * 16 + c], bi = p.b_im[(size_t)idx * 16 + c];
        Bt[((size_t)g * 128 + 32 * jj + q) * 16 + c] = (h16)(cre * br - cim * bi);
        Bt[((size_t)g * 128 + 32 * (2 + jj) + q) * 16 + c] = (h16)(cre * bi + cim * br);
        const float cs = step * 1024.f;
        const float cr = p.c_re[((size_t)g * 16 + c) * 64 + pp], ci = p.c_im[((size_t)g * 16 + c) * 64 + pp];
        Ct[((size_t)g * 16 + c) * 128 + 4 * q + jj] = (h16)(cr * cs);
        Ct[((size_t)g * 16 + c) * 128 + 4 * q + 2 + jj] = (h16)(-ci * cs);
    }
}

template <bool SWAP>
DI void gemm_tile(const h16* __restrict__ A, int lda, const h16* __restrict__ B, int ldb, int K, char* lds, f32x16 (&acc)[4], int tid) {
    const int lane = tid & 63, wave = __builtin_amdgcn_readfirstlane(tid >> 6), q = lane & 31, hf = lane >> 5;
#pragma unroll
    for (int j = 0; j < 4; ++j)
#pragma unroll
        for (int i = 0; i < 16; ++i) acc[j][i] = 0.f;
    const int nk = K >> 6;
    const h16* src[8];
    {
        const int rl = lane >> 3;
#pragma unroll
        for (int i = 0; i < 8; ++i) {
            const int r = 8 * (wave * 8 + i) + rl;
            const int c = (lane & 7) ^ ((4 * (i & 1) + (lane >> 4)) & 7);
            src[i] = (r < 128) ? A + (size_t)r * lda + c * 8 : B + (size_t)(r - 128) * ldb + c * 8;
        }
    }
    const int xs = (q >> 1) & 7;
    int fo[4];
#pragma unroll
    for (int kk = 0; kk < 4; ++kk) fo[kk] = q * 128 + (((kk * 2 + hf) ^ xs) << 4);
#define G_GLDS(stage_, k0_)                                                                                           \
    _Pragma("unroll") for (int i = 0; i < 8; ++i)                                                                     \
        __builtin_amdgcn_global_load_lds((const unsigned*)(src[i] + (k0_)), (unsigned*)(lds + (stage_) * 32768 + (wave * 8 + i) * 1024), 16, 0, 0);
#define G_FRAG(buf_, kk_, FA, FB)                                                                                     \
    FA = *(const h16x8*)(lds + (buf_) * 32768 + wave * (32 * 128) + fo[kk_]);                                         \
    _Pragma("unroll") for (int j = 0; j < 4; ++j)                                                                     \
        FB[j] = *(const h16x8*)(lds + (buf_) * 32768 + 16384 + j * (32 * 128) + fo[kk_]);
#define G_MMA(FA, FB) _Pragma("unroll") for (int j = 0; j < 4; ++j) acc[j] = SWAP ? MFMA32(FB[j], FA, acc[j]) : MFMA32(FA, FB[j], acc[j]);
#define G_STEP(buf_, kload_)                                                                                          \
    {                                                                                                                 \
        h16x8 fa0, fb0[4], fa1, fb1[4];                                                                               \
        asm volatile("s_waitcnt vmcnt(0)" ::: "memory");                                                              \
        __syncthreads();                                                                                              \
        G_GLDS((buf_) ^ 1, kload_);                                                                                   \
        G_FRAG(buf_, 0, fa0, fb0);                                                                                    \
        G_FRAG(buf_, 1, fa1, fb1);                                                                                    \
        __builtin_amdgcn_sched_barrier(0);                                                                            \
        G_MMA(fa0, fb0);                                                                                              \
        __builtin_amdgcn_sched_barrier(0);                                                                            \
        G_FRAG(buf_, 2, fa0, fb0);                                                                                    \
        __builtin_amdgcn_sched_barrier(0);                                                                            \
        G_MMA(fa1, fb1);                                                                                              \
        __builtin_amdgcn_sched_barrier(0);                                                                            \
        G_FRAG(buf_, 3, fa1, fb1);                                                                                    \
        __builtin_amdgcn_sched_barrier(0);                                                                            \
        G_MMA(fa0, fb0);                                                                                              \
        G_MMA(fa1, fb1);                                                                                              \
    }
    __syncthreads();
    G_GLDS(0, 0);
    const int klast = (nk - 1) << 6;
    for (int kt = 0; kt < nk; kt += 2) {
        { const int k0 = min((kt + 1) << 6, klast); G_STEP(0, k0); }
        { const int k1 = min((kt + 2) << 6, klast); G_STEP(1, k1); }
    }
    asm volatile("s_waitcnt vmcnt(0)" ::: "memory");
#undef G_GLDS
#undef G_FRAG
#undef G_MMA
#undef G_STEP
}

template <bool SWAP, bool AGM = false>
DI void gemm_tile256(const h16* __restrict__ A, int lda, const h16* __restrict__ B, int ldb, int K, char* lds, f32x16 (&acc)[2][4], int tid, bool prefetched = false) {
    const int lane = tid & 63, wave = __builtin_amdgcn_readfirstlane(tid >> 6), q = lane & 31, hf = lane >> 5;
#pragma unroll
    for (int hh = 0; hh < 2; ++hh)
#pragma unroll
        for (int j = 0; j < 4; ++j)
#pragma unroll
            for (int i = 0; i < 16; ++i) acc[hh][j][i] = 0.f;
    const int nk = K >> 5;
    const h16* src[6];
    {
        const int rl = lane >> 2, c = (lane & 3) ^ ((lane >> 4) & 3);
#pragma unroll
        for (int i = 0; i < 6; ++i) {
            const int r = 16 * (wave * 6 + i) + rl;
            if (AGM) src[i] = (r < 256) ? A + (size_t)(c >> 1) * TOK * 16 + (size_t)r * 16 + 8 * (c & 1) : B + (size_t)(r - 256) * ldb + c * 8;
            else src[i] = (r < 256) ? A + (size_t)r * lda + c * 8 : B + (size_t)(r - 256) * ldb + c * 8;
        }
    }
#define T_KOFF(i_, k0_) ((AGM && (16 * (wave * 6 + (i_)) < 256)) ? (size_t)(k0_) * TOK : (size_t)(k0_))
    const int xs = (q >> 2) & 3;
    const int fo0 = q * 64 + ((hf ^ xs) << 4), fo1 = q * 64 + (((2 + hf) ^ xs) << 4);
#define T_GLDS(stage_, k0_)                                                                                           \
    _Pragma("unroll") for (int i = 0; i < 6; ++i)                                                                     \
        __builtin_amdgcn_global_load_lds((const unsigned*)(src[i] + T_KOFF(i, k0_)), (unsigned*)(lds + (stage_) * 24576 + (wave * 6 + i) * 1024), 16, 0, 0);
#define T_STEP(buf_, kload_)                                                                                          \
    {                                                                                                                 \
        h16x8 fa[2][2], fb[2][4];                                                                                     \
        asm volatile("s_waitcnt vmcnt(0)" ::: "memory");                                                              \
        __syncthreads();                                                                                              \
        _Pragma("unroll") for (int hh = 0; hh < 2; ++hh) fa[0][hh] = *(const h16x8*)(lds + (buf_) * 24576 + (wave * 64 + hh * 32) * 64 + fo0); \
        _Pragma("unroll") for (int j = 0; j < 4; ++j) fb[0][j] = *(const h16x8*)(lds + (buf_) * 24576 + 16384 + (j * 32) * 64 + fo0); \
        __builtin_amdgcn_sched_barrier(0);                                                                            \
        T_GLDS((buf_) ^ 1, kload_);                                                                                   \
        _Pragma("unroll") for (int hh = 0; hh < 2; ++hh) fa[1][hh] = *(const h16x8*)(lds + (buf_) * 24576 + (wave * 64 + hh * 32) * 64 + fo1); \
        _Pragma("unroll") for (int j = 0; j < 4; ++j) fb[1][j] = *(const h16x8*)(lds + (buf_) * 24576 + 16384 + (j * 32) * 64 + fo1); \
        _Pragma("unroll") for (int kk = 0; kk < 2; ++kk)                                                              \
            _Pragma("unroll") for (int hh = 0; hh < 2; ++hh)                                                          \
                _Pragma("unroll") for (int j = 0; j < 4; ++j) acc[hh][j] = SWAP ? MFMA32(fb[kk][j], fa[kk][hh], acc[hh][j]) : MFMA32(fa[kk][hh], fb[kk][j], acc[hh][j]); \
    }
    if (!prefetched) {
        __syncthreads();
        T_GLDS(0, 0);
    }
    const int klast = (nk - 1) << 5;
    for (int kt = 0; kt < nk; kt += 2) {
        { const int k0 = min((kt + 1) << 5, klast); T_STEP(0, k0); }
        { const int k1 = min((kt + 2) << 5, klast); T_STEP(1, k1); }
    }
    asm volatile("s_waitcnt vmcnt(0)" ::: "memory");
#undef T_GLDS
#undef T_STEP
#undef T_KOFF
}
constexpr int STG256 = 38912;
template <bool AGM>
DI void gemm256_prefetch(const h16* __restrict__ A, int lda, const h16* __restrict__ B, int ldb, char* lds, int tid) {
    const int lane = tid & 63, wave = __builtin_amdgcn_readfirstlane(tid >> 6);
    const int rl = lane >> 2, c = (lane & 3) ^ ((lane >> 4) & 3);
#pragma unroll
    for (int i = 0; i < 6; ++i) {
        const int r = 16 * (wave * 6 + i) + rl;
        const h16* sp;
        if (AGM) sp = (r < 256) ? A + (size_t)(c >> 1) * TOK * 16 + (size_t)r * 16 + 8 * (c & 1) : B + (size_t)(r - 256) * ldb + c * 8;
        else sp = (r < 256) ? A + (size_t)r * lda + c * 8 : B + (size_t)(r - 256) * ldb + c * 8;
        __builtin_amdgcn_global_load_lds((const unsigned*)sp, (unsigned*)(lds + (wave * 6 + i) * 1024), 16, 0, 0);
    }
}
DI bool tile_map256(int bid, int nblk, int it, int NT, int& mt, int& nt) {
    const int x = bid & 7, li = bid >> 3, nper = nblk >> 3;
    const int n = li + it * nper;
    if (n >= 8 * NT) return false;
    mt = x * 8 + (n / (4 * NT)) * 4 + (n & 3);
    nt = (n >> 2) % NT;
    return true;
}

DI void row_scales(const h16* __restrict__ A, int K, int m0, char* lds, int tid) {
    __syncthreads();
    const int row = tid >> 1, half = tid & 1, n = K >> 1;
    const h16* ap = A + (size_t)(m0 + row) * K + half * n;
    float ss = 0.f;
    for (int c = 0; c < n; c += 8) {
        h16x8 v = *(const h16x8*)(ap + c);
#pragma unroll
        for (int e = 0; e < 8; ++e) { float f = (float)v[e]; ss += f * f; }
    }
    ss += __shfl_xor(ss, 1);
    if (half == 0) ((float*)(lds + LDS_RS))[row] = rsqrtf(ss / (float)K + EPS);
    __syncthreads();
}

DI void epi_store(const f32x16 (&acc)[4], h16* __restrict__ dst, int ld, int mrow0, int col0, int q, int hf) {
#pragma unroll
    for (int i = 0; i < 16; ++i) {
        h16* rp = dst + (size_t)(mrow0 + crow(i, hf)) * ld + col0 + q;
#pragma unroll
        for (int j = 0; j < 4; ++j) rp[32 * j] = (h16)acc[j][i];
    }
}
DI void epi_norm128(const f32x16 (&acc)[4], const float* __restrict__ gain, const float* rs, int rsrow0, h16* __restrict__ dst, size_t rowstride,
                    int q, int hf) {
    float g[4];
#pragma unroll
    for (int j = 0; j < 4; ++j) g[j] = gain[32 * j + q];
    const float* rsb = rs ? rs + rsrow0 + 4 * hf : nullptr;
    dst += (size_t)(4 * hf) * rowstride;
#pragma unroll
    for (int i = 0; i < 16; ++i) {
        const int r = (i & 3) + 8 * (i >> 2);
        const float pre = rsb ? rsb[r] : 1.f;
        float v[4]; float ss = 0.f;
#pragma unroll
        for (int j = 0; j < 4; ++j) { v[j] = acc[j][i] * pre; ss += v[j] * v[j]; }
        ss = half_sum(ss);
        const float sc = rsqrtf(ss * (1.f / 128.f) + EPS);
        h16* rp = dst + (size_t)r * rowstride + q;
#pragma unroll
        for (int j = 0; j < 4; ++j) rp[32 * j] = (h16)(v[j] * sc * g[j]);
    }
}

DI void fast_sincos(float x, float& s, float& c) {
    const float k = rintf(x * 0.15915494309189535f);
    float r = fmaf(-k, 6.28125f, x);
    r = fmaf(-k, 0.0019353071795864769f, r);
    s = __sinf(r); c = __cosf(r);
}
DI void t_store(const f32x16 (&acc)[4], h16* __restrict__ rowp, int hf, float pre) {
#pragma unroll
    for (int j = 0; j < 4; ++j)
#pragma unroll
        for (int g4 = 0; g4 < 4; ++g4) {
            h16x4 v;
#pragma unroll
            for (int e = 0; e < 4; ++e) v[e] = (h16)(acc[j][4 * g4 + e] * pre);
            *(h16x4*)(rowp + 32 * j + 8 * g4 + 4 * hf) = v;
        }
}
DI void t_silu_store(const f32x16 (&acc)[4], h16* __restrict__ rowp, int hf) {
#pragma unroll
    for (int j = 0; j < 4; ++j)
#pragma unroll
        for (int g4 = 0; g4 < 4; ++g4) {
            h16x4 v;
#pragma unroll
            for (int e = 0; e < 4; ++e) v[e] = (h16)siluf_(acc[j][4 * g4 + e]);
            *(h16x4*)(rowp + 32 * j + 8 * g4 + 4 * hf) = v;
        }
}
DI void t_norm128(const f32x16 (&acc)[4], float pre, h16* __restrict__ rowp, int hf) {
    float ss = 0.f;
#pragma unroll
    for (int j = 0; j < 4; ++j)
#pragma unroll
        for (int i = 0; i < 16; ++i) { const float v = acc[j][i] * pre; ss += v * v; }
    ss += __shfl_xor(ss, 32);
    const float sc = rsqrtf(ss * (1.f / 128.f) + EPS) * pre;
    t_store(acc, rowp, hf, sc);
}
DI void wave_lds_fence() {
    asm volatile("s_waitcnt lgkmcnt(0)" ::: "memory");
    __builtin_amdgcn_wave_barrier();
}
DI void t_flush128(const char* stg, h16* __restrict__ dst, int ld, int lane) {
    wave_lds_fence();
#pragma unroll
    for (int r4 = 0; r4 < 8; ++r4) {
        const int row = 4 * r4 + (lane >> 4), c = lane & 15;
        const h16x8 x = *(const h16x8*)(stg + row * 272 + c * 16);
        *(h16x8*)(dst + (size_t)row * ld + c * 8) = x;
    }
    wave_lds_fence();
}
DI void t_flush128g(const char* stg, h16* __restrict__ dst, int ld, const float* __restrict__ gain, int lane) {
    wave_lds_fence();
    const int c = lane & 15;
    const float4 g0 = *(const float4*)(gain + c * 8), g1 = *(const float4*)(gain + c * 8 + 4);
#pragma unroll
    for (int r4 = 0; r4 < 8; ++r4) {
        const int row = 4 * r4 + (lane >> 4);
        const h16x8 x = *(const h16x8*)(stg + row * 272 + c * 16);
        h16x8 o;
        o[0] = (h16)((float)x[0] * g0.x); o[1] = (h16)((float)x[1] * g0.y); o[2] = (h16)((float)x[2] * g0.z); o[3] = (h16)((float)x[3] * g0.w);
        o[4] = (h16)((float)x[4] * g1.x); o[5] = (h16)((float)x[5] * g1.y); o[6] = (h16)((float)x[6] * g1.z); o[7] = (h16)((float)x[7] * g1.w);
        *(h16x8*)(dst + (size_t)row * ld + c * 8) = o;
    }
    wave_lds_fence();
}
DI void t_flush128_mul(const char* stg, h16* __restrict__ dst, int ld, int lane) {
    wave_lds_fence();
    const int c = lane & 15;
    h16x8 sg[8];
#pragma unroll
    for (int r4 = 0; r4 < 8; ++r4) sg[r4] = *(const h16x8*)(dst + (size_t)(4 * r4 + (lane >> 4)) * ld + c * 8);
#pragma unroll
    for (int r4 = 0; r4 < 8; ++r4) {
        const int row = 4 * r4 + (lane >> 4);
        const h16x8 x = *(const h16x8*)(stg + row * 272 + c * 16);
        h16x8 o;
#pragma unroll
        for (int e = 0; e < 8; ++e) o[e] = (h16)((float)x[e] * (float)sg[r4][e]);
        *(h16x8*)(dst + (size_t)row * ld + c * 8) = o;
    }
    wave_lds_fence();
}
DI void t_flush64(const char* stg, h16* __restrict__ dst, int ld, int lane) {
    wave_lds_fence();
#pragma unroll
    for (int r4 = 0; r4 < 4; ++r4) {
        const int row = 8 * r4 + (lane >> 3), c = lane & 7;
        const h16x8 x = *(const h16x8*)(stg + row * 272 + c * 16);
        *(h16x8*)(dst + (size_t)row * ld + c * 8) = x;
    }
    wave_lds_fence();
}
DI void t_flush64_mul(const char* stg, h16* __restrict__ dst, int ld, int lane) {
    wave_lds_fence();
    h16x8 sg[4];
#pragma unroll
    for (int r4 = 0; r4 < 4; ++r4) sg[r4] = *(const h16x8*)(dst + (size_t)(8 * r4 + (lane >> 3)) * ld + (lane & 7) * 8);
#pragma unroll
    for (int r4 = 0; r4 < 4; ++r4) {
        const int row = 8 * r4 + (lane >> 3), c = lane & 7;
        const h16x8 x = *(const h16x8*)(stg + row * 272 + c * 16);
        h16x8 o;
#pragma unroll
        for (int e = 0; e < 8; ++e) o[e] = (h16)((float)x[e] * (float)sg[r4][e]);
        *(h16x8*)(dst + (size_t)row * ld + c * 8) = o;
    }
    wave_lds_fence();
}
DI void t_flush_gm(const char* stg, h16* __restrict__ dst  , int lane) {
    wave_lds_fence();
    const int row = lane >> 1, half = lane & 1;
#pragma unroll
    for (int k = 0; k < 8; ++k) {
        const h16x8 x = *(const h16x8*)(stg + row * 272 + k * 32 + half * 16);
        *(h16x8*)(dst + (size_t)k * TOK * 16 + row * 16 + half * 8) = x;
    }
    wave_lds_fence();
}
DI void t_rowss(const f32x16 (&acc)[4], float pre, float* __restrict__ ssum_tok, int hf) {
    float ss = 0.f;
#pragma unroll
    for (int j = 0; j < 4; ++j)
#pragma unroll
        for (int i = 0; i < 16; ++i) { const float v = acc[j][i] * pre; ss += v * v; }
    ss += __shfl_xor(ss, 32);
    if (hf == 0) atomicAdd(ssum_tok, ss);
}
DI void t_epi(const f32x16 (&acc)[4], int mode, const float* gain, float pre, char* stg, h16* __restrict__ dst, int ld, int q, int hf, int lane) {
    float sc = pre;
    if (mode == 1) {
        float ss = 0.f;
#pragma unroll
        for (int j = 0; j < 4; ++j)
#pragma unroll
            for (int i = 0; i < 16; ++i) { const float v = acc[j][i] * pre; ss += v * v; }
        ss += __shfl_xor(ss, 32);
        sc = rsqrtf(ss * (1.f / 128.f) + EPS) * pre;
    }
    h16* srow = (h16*)(stg + q * 272) + 4 * hf;
#pragma unroll
    for (int j = 0; j < 4; ++j)
#pragma unroll
        for (int g4 = 0; g4 < 4; ++g4) {
            h16x4 v;
            if (mode == 2) {
#pragma unroll
                for (int e = 0; e < 4; ++e) v[e] = (h16)siluf_(acc[j][4 * g4 + e] * pre);
            } else {
#pragma unroll
                for (int e = 0; e < 4; ++e) v[e] = (h16)(acc[j][4 * g4 + e] * sc);
            }
            *(h16x4*)(srow + 32 * j + 8 * g4) = v;
        }
    if (mode == 1) t_flush128g(stg, dst, ld, gain, lane);
    else if (ld == 0) t_flush_gm(stg, dst, lane);
    else t_flush128(stg, dst, ld, lane);
}
DI void t_rope64(const f32x16& a0, const f32x16& a1, const float* __restrict__ gain, float pre, float posf, h16* __restrict__ rowp, int hf) {
    float ss = 0.f;
#pragma unroll
    for (int i = 0; i < 16; ++i) { const float v0 = a0[i] * pre, v1 = a1[i] * pre; ss += v0 * v0 + v1 * v1; }
    ss += __shfl_xor(ss, 32);
    const float sc = rsqrtf(ss * (1.f / 64.f) + EPS) * pre;
#pragma unroll
    for (int g4 = 0; g4 < 4; ++g4) {
        h16x4 o1, o2;
#pragma unroll
        for (int e = 0; e < 4; ++e) {
            const int d = 8 * g4 + 4 * hf + e;
            const float invf = exp2f(-(float)d * 0.41524101186092029f);
            float sn, cs; fast_sincos(posf * invf, sn, cs);
            const float x1 = a0[4 * g4 + e] * sc * gain[d], x2 = a1[4 * g4 + e] * sc * gain[32 + d];
            o1[e] = (h16)(x1 * cs - x2 * sn); o2[e] = (h16)(x1 * sn + x2 * cs);
        }
        *(h16x4*)(rowp + 8 * g4 + 4 * hf) = o1;
        *(h16x4*)(rowp + 32 + 8 * g4 + 4 * hf) = o2;
    }
}

template <int DK, bool CAUSAL>
DI void attn_item(const h16* __restrict__ Qb, int qstride, const h16* __restrict__ Kn, int knstride, const h16* __restrict__ Kr,
                  const h16* __restrict__ Vt, int vtstride, int vtile, int nkt, int q0, h16* __restrict__ outb, int ostride, float sc,
                  char* lds, int tid) {
    constexpr int KSTR = (DK + 8) * 2;
    constexpr int CPK = DK / 8;
    constexpr int NKC = 64 * CPK / 256;
    constexpr int NKS = DK / 16;
    char* Ks = lds; char* Vs = lds + 64 * KSTR;
    const int lane = tid & 63, wave = __builtin_amdgcn_readfirstlane(tid >> 6), q = lane & 31, hf = lane >> 5;
    h16x8 qf[NKS];
#pragma unroll
    for (int ks = 0; ks < NKS; ++ks) qf[ks] = *(const h16x8*)(Qb + (size_t)(wave * 32 + q) * qstride + 16 * ks + 8 * hf);
    h16x8 kreg[NKC], vreg[4];
    f32x16 o[4];
#pragma unroll
    for (int j = 0; j < 4; ++j)
#pragma unroll
        for (int i = 0; i < 16; ++i) o[j][i] = 0.f;
    float m_run = -1e30f, l_run = 0.f;
    const int qw0 = q0 + wave * 32, qglob = qw0 + q;
    const int sq = swap23(q);

    const int tk_off = (tid >> 4) * knstride + (tid & 15) * 8;
    const int tr_off = (tid >> 3) * 64 + (tid & 7) * 8;
    const int tv_off = (tid >> 3) * vtstride + (tid & 7) * 8;
    const int lk_off = (tid >> 4) * KSTR + (tid & 15) * 16;
    const int lr_off = (tid >> 3) * KSTR + 256 + (tid & 7) * 16;
    const int lv_off = (tid >> 3) * 144 + (tid & 7) * 16;
#define ATT_LOAD(kt_)                                                                                                 \
    {                                                                                                                 \
        const h16* knp = Kn + (size_t)((kt_) * 64) * knstride;                                                        \
        _Pragma("unroll") for (int i = 0; i < 4; ++i) kreg[i] = *(const h16x8*)(knp + (16 * i) * knstride + tk_off);  \
        if (DK == 192) {                                                                                              \
            const h16* krp = Kr + (size_t)((kt_) * 64) * 64;                                                          \
            _Pragma("unroll") for (int i = 0; i < NKC - 4; ++i) kreg[4 + i] = *(const h16x8*)(krp + (32 * i) * 64 + tr_off); \
        }                                                                                                             \
        const h16* vp = Vt + (size_t)(kt_) * vtile;                                                                   \
        _Pragma("unroll") for (int i = 0; i < 4; ++i) vreg[i] = *(const h16x8*)(vp + (32 * i) * vtstride + tv_off);   \
    }
    ATT_LOAD(0);
    for (int kt = 0; kt < nkt; ++kt) {
        __syncthreads();
#pragma unroll
        for (int i = 0; i < 4; ++i) *(h16x8*)(Ks + lk_off + (16 * i) * KSTR) = kreg[i];
        if (DK == 192) {
#pragma unroll
            for (int i = 0; i < NKC - 4; ++i) *(h16x8*)(Ks + lr_off + (32 * i) * KSTR) = kreg[4 + i];
        }
#pragma unroll
        for (int i = 0; i < 4; ++i) *(h16x8*)(Vs + lv_off + (32 * i) * 144) = vreg[i];
        __syncthreads();
        if (kt + 1 < nkt) ATT_LOAD(kt + 1);
        const bool skip = CAUSAL && (64 * kt > qw0 + 31);
        if (!skip) {
            f32x16 s0, s1;
#pragma unroll
            for (int i = 0; i < 16; ++i) { s0[i] = 0.f; s1[i] = 0.f; }
#pragma unroll
            for (int ks = 0; ks < NKS; ++ks) {
                h16x8 k0 = *(const h16x8*)(Ks + sq * KSTR + (16 * ks + 8 * hf) * 2);
                h16x8 k1 = *(const h16x8*)(Ks + (32 + sq) * KSTR + (16 * ks + 8 * hf) * 2);
                s0 = MFMA32(k0, qf[ks], s0);
                s1 = MFMA32(k1, qf[ks], s1);
            }
            const bool needmask = CAUSAL && (64 * kt + 63 > qw0);
            float mx = -1e30f;
            if (needmask) {
#pragma unroll
                for (int i = 0; i < 16; ++i) {
                    const int key = kt * 64 + 16 * (i >> 3) + 8 * hf + (i & 7);
                    if (key > qglob) s0[i] = -1e30f;
                    if (key + 32 > qglob) s1[i] = -1e30f;
                }
            }
#pragma unroll
            for (int i = 0; i < 16; ++i) mx = fmaxf(mx, fmaxf(s0[i], s1[i]));
            mx = fmaxf(mx, __shfl_xor(mx, 32));
            const float mnew = fmaxf(m_run, mx);
            const float alpha = __builtin_amdgcn_exp2f((m_run - mnew) * sc);
            m_run = mnew;
            const float msc = mnew * sc;
            float rsum = 0.f;
#pragma unroll
            for (int i = 0; i < 16; ++i) {
                float p0 = __builtin_amdgcn_exp2f(fmaf(s0[i], sc, -msc)), p1 = __builtin_amdgcn_exp2f(fmaf(s1[i], sc, -msc));
                s0[i] = p0; s1[i] = p1; rsum += p0 + p1;
            }
            l_run = l_run * alpha + rsum;
            if (__builtin_amdgcn_ballot_w64(alpha != 1.f) != 0ull) {
#pragma unroll
                for (int j = 0; j < 4; ++j)
#pragma unroll
                    for (int i = 0; i < 16; ++i) o[j][i] *= alpha;
            }
#pragma unroll
            for (int t2 = 0; t2 < 4; ++t2) {
                h16x8 pf;
#pragma unroll
                for (int e = 0; e < 8; ++e) pf[e] = (h16)((t2 < 2) ? s0[8 * (t2 & 1) + e] : s1[8 * (t2 & 1) + e]);
#pragma unroll
                for (int j = 0; j < 4; ++j) {
                    h16x8 vf = *(const h16x8*)(Vs + (32 * j + q) * 144 + (16 * t2 + 8 * hf) * 2);
                    o[j] = MFMA32(vf, pf, o[j]);
                }
            }
        }
    }
#undef ATT_LOAD
    const float l = l_run + __shfl_xor(l_run, 32);
    const float inv = 1.f / l;
    __syncthreads();
    {
        char* stg = lds + wave * 8704;
        t_store(o, (h16*)(stg + q * 272), hf, inv);
        t_flush128_mul(stg, outb + (size_t)(wave * 32) * ostride, ostride, lane);
    }
}

DI void mem_attn_phase(const P& p, int layer, int* ctr, char* lds, int tid) {
    const h16* xq = (const h16*)(p.ws + (layer ? OFF_XQ1 : OFF_XQ0));
    const h16* mk = (const h16*)(p.ws + (layer ? OFF_MEMK1 : OFF_MEMK0));
    const h16* mvt = (const h16*)(p.ws + (layer ? OFF_MEMVT1 : OFF_MEMVT0));
    h16* obuf = (h16*)(p.ws + OFF_OBUF);
    volatile int* sitem = (volatile int*)(lds + LDS_ITEM);
    const float sc = 0.08838834764831845f * LOG2E;
    for (;;) {
        __syncthreads();
        if (tid == 0) *sitem = atomicAdd(ctr, 1);
        __syncthreads();
        const int it = *sitem;
        if (it >= 512) break;
        const int b = it >> 6, h = (it >> 4) & 3, qt = it & 15;
        const size_t row0 = (size_t)b * SEQ + qt * 128;
        attn_item<128, false>(xq + row0 * 512 + h * 128, 512, mk + (size_t)((b * 4 + h) * 256) * 128, 128, nullptr,
                              mvt + (size_t)((b * 4 + h) * 128) * 256, 256, 64, 4, 0, obuf + row0 * 2048 + 1536 + h * 128, 2048, sc, lds, tid);
    }
}

template <bool FULL>
DI void s5_seg(const P& p, int g, int bp, int s, char* ldsw, int lane) {
    const h16* u = (const h16*)(p.ws + OFF_U);
    h16* yg = (h16*)(p.ws + OFF_YG);
    const float* At = (const float*)(p.ws + OFF_S5A);
    const h16* Bt = (const h16*)(p.ws + OFF_S5B);
    const h16* Ct = (const h16*)(p.ws + OFF_S5C);
    float4* E = (float4*)(p.ws + OFF_S5E);
    const int q = lane & 31, hf = lane >> 5, c16 = lane & 15, l4 = lane >> 4;
    h16x8 bfr[4];
#pragma unroll
    for (int j = 0; j < 4; ++j) bfr[j] = *(const h16x8*)(Bt + ((size_t)g * 128 + 32 * j + q) * 16 + 8 * hf);
    const float are0 = At[(g * 64 + q) * 2], aim0 = At[(g * 64 + q) * 2 + 1];
    const float are1 = At[(g * 64 + q + 32) * 2], aim1 = At[(g * 64 + q + 32) * 2 + 1];
    float hr0 = 0.f, hi0 = 0.f, hr1 = 0.f, hi1 = 0.f;
    const size_t eidx = (size_t)((g * 4 + bp) * 16) * 64 + hf * 32 + q;
    h16x8 cfr[4];
    float dq = 0.f;
    if (FULL) {
#pragma unroll
        for (int ks = 0; ks < 4; ++ks) cfr[ks] = *(const h16x8*)(Ct + ((size_t)g * 16 + c16) * 128 + 32 * ks + 8 * l4);
        dq = 0.f;
        const float* A128 = (const float*)(p.ws + OFF_S5A128);
        const float pr0 = A128[(g * 64 + q) * 2], pi0 = A128[(g * 64 + q) * 2 + 1];
        const float pr1 = A128[(g * 64 + q + 32) * 2], pi1 = A128[(g * 64 + q + 32) * 2 + 1];
        for (int j = 0; j < s; ++j) {
            const float4 e = E[eidx + (size_t)j * 64];
            const float nr0 = fmaf(pr0, hr0, fmaf(-pi0, hi0, e.x)), ni0 = fmaf(pr0, hi0, fmaf(pi0, hr0, e.z));
            const float nr1 = fmaf(pr1, hr1, fmaf(-pi1, hi1, e.y)), ni1 = fmaf(pr1, hi1, fmaf(pi1, hr1, e.w));
            hr0 = nr0; hi0 = ni0; hr1 = nr1; hi1 = ni1;
        }
    }
    const int aseq = (q >> 2) & 1, att = (q & 3) + 4 * (q >> 3);
    const h16* ua = u + (size_t)g * TOK * 16 + ((size_t)(2 * bp + aseq) * SEQ + s * 128 + att) * 16 + 8 * hf;
    const float4 d4 = FULL ? *(const float4*)(p.s5_d + g * 16 + 4 * l4) : make_float4(0.f, 0.f, 0.f, 0.f);
    char* us = ldsw + 8704;
    h16x8 afn = *(const h16x8*)ua;
    for (int ch = 0; ch < 8; ++ch) {
        const h16x8 af = afn;
        if (ch + 1 < 8) afn = *(const h16x8*)(ua + (size_t)(ch + 1) * 16 * 16);
        f32x16 z;
#pragma unroll
        for (int i = 0; i < 16; ++i) z[i] = 0.f;
        f32x16 a0 = MFMA32(af, bfr[0], z), a1 = MFMA32(af, bfr[1], z), a2 = MFMA32(af, bfr[2], z), a3 = MFMA32(af, bfr[3], z);
        if (FULL) *(h16x8*)(us + (aseq * 16 + att) * 32 + hf * 16) = af;
#pragma unroll
        for (int i = 0; i < 16; ++i) {
            const float nr0 = fmaf(are0, hr0, fmaf(-aim0, hi0, a0[i]));
            const float ni0 = fmaf(are0, hi0, fmaf(aim0, hr0, a2[i]));
            const float nr1 = fmaf(are1, hr1, fmaf(-aim1, hi1, a1[i]));
            const float ni1 = fmaf(are1, hi1, fmaf(aim1, hr1, a3[i]));
            hr0 = nr0; hi0 = ni0; hr1 = nr1; hi1 = ni1;
            if (FULL) {
                h16x4 hv; hv[0] = (h16)hr0; hv[1] = (h16)hr1; hv[2] = (h16)hi0; hv[3] = (h16)hi1;
                *(h16x4*)(ldsw + (hf * 16 + i) * 272 + q * 8) = hv;
            }
        }
        if (FULL) {
            asm volatile("s_waitcnt lgkmcnt(0)" ::: "memory");
            __builtin_amdgcn_wave_barrier();
#pragma unroll
            for (int sq = 0; sq < 2; ++sq) {
                f32x4 y; y[0] = 0.f; y[1] = 0.f; y[2] = 0.f; y[3] = 0.f;
#pragma unroll
                for (int ks = 0; ks < 4; ++ks) {
                    const h16x8 hfr = *(const h16x8*)(ldsw + (sq * 16 + c16) * 272 + (32 * ks + 8 * l4) * 2);
                    y = MFMA16(cfr[ks], hfr, y);
                }
                const h16x4 uu = *(const h16x4*)(us + (sq * 16 + c16) * 32 + l4 * 8);
                h16x4 ov;
                ov[0] = (h16)geluf_(y[0] * (1.f / 1024.f) + d4.x * (float)uu[0]);
                ov[1] = (h16)geluf_(y[1] * (1.f / 1024.f) + d4.y * (float)uu[1]);
                ov[2] = (h16)geluf_(y[2] * (1.f / 1024.f) + d4.z * (float)uu[2]);
                ov[3] = (h16)geluf_(y[3] * (1.f / 1024.f) + d4.w * (float)uu[3]);
                *(h16x4*)(yg + (size_t)g * TOK * 16 + ((size_t)(2 * bp + sq) * SEQ + s * 128 + ch * 16 + c16) * 16 + 4 * l4) = ov;
            }
            asm volatile("s_waitcnt lgkmcnt(0)" ::: "memory");
            __builtin_amdgcn_wave_barrier();
        }
    }
    if (!FULL) E[eidx + (size_t)s * 64] = make_float4(hr0, hr1, hi0, hi1);
}

#define XB_TMO      128
#define XB_XCNT(j)  (256  + 64 * (j))
#define XB_XSUB(j)  (1280 + 64 * (j))
#define XB_XGEN(j)  (2304 + 64 * (j))
#define XB_TOP      3328
#define XB_TOPGEN   3392
#define XCD_BAR_WORDS 3456
#define XB_SPIN_CAP (1u << 22)
#define LAS __attribute__((address_space(3)))
DI unsigned xb_ld(unsigned* p) { return __hip_atomic_load(p, __ATOMIC_RELAXED, __HIP_MEMORY_SCOPE_AGENT); }
DI unsigned xb_add(unsigned* p, unsigned v) { return __hip_atomic_fetch_add(p, v, __ATOMIC_RELAXED, __HIP_MEMORY_SCOPE_AGENT); }
DI unsigned xb_xcc_id() { return (unsigned)__builtin_amdgcn_s_getreg((3 << 11) | 20) & 0xFu; }
#define XB_SPIN(cond, bar) do { unsigned _sp = 0; while (cond) { __builtin_amdgcn_s_sleep(1); \
    if ((++_sp & 255u) == 0u) { if (xb_ld(&(bar)[XB_TMO])) break; if (_sp > XB_SPIN_CAP) { atomicAdd(&(bar)[XB_TMO], 1u); break; } } } } while (0)
struct XcdBarrier { unsigned* bar; unsigned x; volatile LAS unsigned* st; };
DI XcdBarrier xcd_barrier_post(unsigned* bar, volatile LAS unsigned* st) {
    XcdBarrier b; b.bar = bar; b.x = xb_xcc_id(); b.st = st;
    if (threadIdx.x == 0) (void)xb_add(&bar[XB_XCNT(b.x)], 1u);
    return b;
}
DI void xcd_barrier_complete(unsigned* bar, unsigned x, unsigned& nloc, unsigned& nx) {
    const unsigned G = gridDim.x * gridDim.y * gridDim.z;
    unsigned sum, cnt, mine, sp = 0u;
    for (;;) {
        sum = 0u; cnt = 0u; mine = 0u;
#pragma unroll
        for (unsigned j = 0; j < 16; ++j) { const unsigned c = xb_ld(&bar[XB_XCNT(j)]); sum += c; cnt += (c > 0u) ? 1u : 0u; mine = (j == x) ? c : mine; }
        if (sum == G) break;
        __builtin_amdgcn_s_sleep(1);
        if ((++sp & 255u) == 0u) { if (xb_ld(&bar[XB_TMO])) break; if (sp > XB_SPIN_CAP) { atomicAdd(&bar[XB_TMO], 1u); break; } }
    }
    nloc = mine > 0u ? mine : 1u; nx = cnt > 0u ? cnt : 1u;
}
DI void xcd_barrier(const XcdBarrier& b) {
    asm volatile("s_waitcnt vmcnt(0)" ::: "memory");
    __syncthreads();
    if (threadIdx.x == 0) {
        unsigned* bar = b.bar;
        __builtin_amdgcn_s_waitcnt(0);
        unsigned nloc = b.st[0], nx = b.st[1];
        if (nloc == 0u) { xcd_barrier_complete(bar, b.x, nloc, nx); b.st[0] = nloc; b.st[1] = nx; }
        const unsigned old = xb_add(&bar[XB_XSUB(b.x)], 1u);
        const unsigned gen = old / nloc;
        if (old + 1u == (gen + 1u) * nloc) {
            __builtin_amdgcn_fence(__ATOMIC_RELEASE, "agent");
            asm volatile("s_waitcnt vmcnt(0)" ::: "memory");
            const unsigned og = xb_add(&bar[XB_TOP], 1u);
            const unsigned tg = og / nx;
            if (og + 1u == (tg + 1u) * nx) xb_add(&bar[XB_TOPGEN], 1u);
            else XB_SPIN(xb_ld(&bar[XB_TOPGEN]) == tg, bar);
            __builtin_amdgcn_fence(__ATOMIC_ACQUIRE, "agent");
            xb_add(&bar[XB_XGEN(b.x)], 1u);
            asm volatile("s_waitcnt vmcnt(0)" ::: "memory");
        } else {
            XB_SPIN(xb_ld(&bar[XB_XGEN(b.x)]) == gen, bar);
            __builtin_amdgcn_fence(__ATOMIC_ACQUIRE, "agent");
            asm volatile("s_waitcnt vmcnt(0)" ::: "memory");
        }
    }
    __syncthreads();
}

DI bool tile_map(int bid, int nblk, int it, int NT, int& mt, int& nt) {
    const int x = bid & 7, li = bid >> 3, nper = nblk >> 3;
    const int n = li + it * nper;
    if (n >= 16 * NT) return false;
    mt = x * 16 + (n / (8 * NT)) * 8 + (n & 7);
    nt = (n >> 3) % NT;
    return true;
}

__global__ void __launch_bounds__(256, 2) mega(P p, int lo, int hi) {
    __shared__ __attribute__((aligned(16))) char lds[LDS_BYTES];
    cg::grid_group grid = cg::this_grid();
#define IDS const int tid = threadIdx.x, lane = tid & 63, wave = __builtin_amdgcn_readfirstlane(tid >> 6), q = lane & 31, hf = lane >> 5; const int bid = blockIdx.x, nblk = gridDim.x; (void)lane; (void)wave; (void)q; (void)hf; (void)bid; (void)nblk;
    int* ctr = (int*)(p.ws + OFF_CTR);
    h16* obuf = (h16*)(p.ws + OFF_OBUF);
    const float* rs = (const float*)(lds + LDS_RS);

#ifndef ONLY
#define ONLY -1
#endif
#define RUN(k) ((ONLY < 0 || ONLY == (k)) && lo <= (k) && (k) < hi)
#define SYNC(k) if (RUN(k) && RUN((k) + 1)) xcd_barrier(xb);
    if (threadIdx.x < 4) ((volatile LAS unsigned*)(lds + LDS_XB))[threadIdx.x] = 0u;
    __syncthreads();
    XcdBarrier xb = xcd_barrier_post((unsigned*)(p.ws + OFF_BAR), (volatile LAS unsigned*)(lds + LDS_XB));
    if (hi > 1000) grid.sync();
    if (RUN(0)) {
            IDS
            for (int rep = 0; rep < NREP(0); ++rep)
            { int rot = 0; for (int m = 0; m < 7; ++m) rot += conv_matrix(p, m, bid, nblk, (float*)lds, tid, rot); }
            rmsnorm_rows(p.x, p.ln_gain, (h16*)(p.ws + OFF_XN0), TOK, bid * 4 + wave, nblk * 4, lane);
            rmsnorm_rows(p.mem, p.mem_norm, (h16*)(p.ws + OFF_MEMN0), 2048, bid * 4 + wave, nblk * 4, lane);
            rmsnorm_rows(p.mem, p.mem_norm + DM, (h16*)(p.ws + OFF_MEMN1), 2048, bid * 4 + wave, nblk * 4, lane);
            s5_tables(p, bid * 256 + tid, nblk * 256);
            for (int i = bid * 256 + tid; i < 3 * TOK; i += nblk * 256) ((float*)(p.ws + OFF_ROWSS))[i] = 0.f;
    }
    SYNC(0)
    if (RUN(1)) {
            IDS
            const h16* xn = (const h16*)(p.ws + OFF_XN0);
            const h16* w = (const h16*)(p.ws + OFF_WIN0);
            for (int rep = 0; rep < NREP(1); ++rep)
            for (int it = 0;; ++it) {
                int mt, nt;
                if (!tile_map256(bid, nblk, it, 32, mt, nt)) break;
                const int m0 = mt * 256, n0 = nt * 128;
                f32x16 acc2[2][4];
                gemm_tile256<true>(xn + (size_t)m0 * DM, DM, w + (size_t)n0 * DM, DM, DM, lds, acc2, tid);
                __syncthreads();
                char* stg = lds + wave * 8704;
                const size_t rw = (size_t)(m0 + wave * 64);
                const int mode = (n0 < 1536) ? 0 : (n0 < 2048 ? 1 : 2);
                h16* dst = (n0 < 1536) ? (h16*)(p.ws + OFF_U) + (size_t)(n0 >> 4) * TOK * 16 + rw * 16
                         : (n0 < 2048) ? (h16*)(p.ws + OFF_XQ0) + rw * 512 + (n0 - 1536) : obuf + rw * 2048 + (n0 - 2048);
                const int ld = (n0 < 1536) ? 0 : (n0 < 2048 ? 512 : 2048);
                const int hstep = (n0 < 1536) ? 32 * 16 : 32 * ld;
#pragma unroll
                for (int hh = 0; hh < 2; ++hh) t_epi(acc2[hh], mode, p.xq_norm, 1.f, stg, dst + (size_t)hh * hstep, ld, q, hf, lane);
            }
            for (int t2 = bid; t2 < 256; t2 += nblk) {
                f32x16 acc[4];
                const int layer = t2 >> 7, mt = (t2 >> 3) & 15, nt = t2 & 7;
                const h16* mn = (const h16*)(p.ws + (layer ? OFF_MEMN1 : OFF_MEMN0));
                const h16* wm = (const h16*)(p.ws + (layer ? OFF_WMKV1 : OFF_WMKV0));
                const int m0 = mt * 128, b = m0 >> 8, key0 = m0 & 255;
                if (nt < 4) {
                    gemm_tile<true>(mn + (size_t)m0 * DM, DM, wm + (size_t)(nt * 128) * DM, DM, DM, lds, acc, tid);
                    h16* mk = (h16*)(p.ws + (layer ? OFF_MEMK1 : OFF_MEMK0));
                    __syncthreads();
                    char* stg = lds + wave * 8704;
                    t_norm128(acc, 1.f, (h16*)(stg + q * 272), hf);
                    t_flush128g(stg, mk + (size_t)((b * 4 + nt) * 256 + key0 + wave * 32) * 128, 128, p.xk_norm + layer * 128, lane);
                } else {
                    const int h = nt - 4;
                    gemm_tile<false>(mn + (size_t)m0 * DM, DM, wm + (size_t)(512 + h * 128) * DM, DM, DM, lds, acc, tid);
                    h16* mvt = (h16*)(p.ws + (layer ? OFF_MEMVT1 : OFF_MEMVT0)) + (size_t)((b * 4 + h) * 128) * 256 + key0 + wave * 32 + 4 * hf;
#pragma unroll
                    for (int j = 0; j < 4; ++j)
#pragma unroll
                        for (int g4 = 0; g4 < 4; ++g4) {
                            h16x4 v;
#pragma unroll
                            for (int e = 0; e < 4; ++e) v[e] = (h16)acc[j][4 * g4 + e];
                            *(h16x4*)(mvt + (size_t)(32 * j + q) * 256 + 8 * g4) = v;
                        }
                }
            }
    }
    SYNC(1)
    if (RUN(2)) {
            IDS
            for (int it = bid * 4 + wave; it < 6144; it += 4 * nblk)
                if ((it & 15) != 15) s5_seg<false>(p, it >> 6, (it >> 4) & 3, it & 15, lds + wave * 9728, lane);
            mem_attn_phase(p, 0, ctr + 0, lds, tid);
    }
    SYNC(2)
    if (RUN(3)) {
            IDS
            for (int it = bid * 4 + wave; it < 6144; it += 4 * nblk)
                s5_seg<true>(p, it >> 6, (it >> 4) & 3, it & 15, lds + wave * 9728, lane);
    }
    SYNC(3)
    if (RUN(4)) {
            IDS
            const h16* ygp = (const h16*)(p.ws + OFF_YG);
            const h16* w = (const h16*)(p.ws + OFF_WGLU);
            bool pre = false;
            for (int it = 0;; ++it) {
                int mt, nt;
                if (!tile_map256(bid, nblk, it, 24, mt, nt)) break;
                const int m0 = mt * 256;
                f32x16 acc2[2][4];
                gemm_tile256<true, true>(ygp + (size_t)m0 * 16, 0, w + (size_t)(nt * 128) * 1536, 1536, 1536, lds, acc2, tid, pre);
                __syncthreads();
                {
                    int mt2, nt2;
                    pre = tile_map256(bid, nblk, it + 1, 24, mt2, nt2);
                    if (pre) gemm256_prefetch<true>(ygp + (size_t)(mt2 * 256) * 16, 0, w + (size_t)(nt2 * 128) * 1536, 1536, lds, tid);
                }
                char* stg = lds + STG256 + wave * 8704;
#pragma unroll
                for (int hh = 0; hh < 2; ++hh) {
                    h16* srow = (h16*)(stg + q * 272) + 4 * hf;
#pragma unroll
                    for (int j = 0; j < 2; ++j)
#pragma unroll
                        for (int g4 = 0; g4 < 4; ++g4) {
                            h16x4 v;
#pragma unroll
                            for (int e = 0; e < 4; ++e) v[e] = (h16)(acc2[hh][j][4 * g4 + e] * sigmoidf_(acc2[hh][j + 2][4 * g4 + e]));
                            *(h16x4*)(srow + 32 * j + 8 * g4) = v;
                        }
                    t_flush64_mul(stg, obuf + (size_t)(m0 + wave * 64 + hh * 32) * 2048 + nt * 64, 2048, lane);
                }
            }
    }
    SYNC(4)
    if (RUN(5)) {
            IDS
            const h16* w = (const h16*)(p.ws + OFF_WOUT0);
            const float* xin = p.x;
            float* rowss = (float*)(p.ws + OFF_ROWSS);
            h16* xr = (h16*)(p.ws + OFF_XN1);
            for (int it = 0;; ++it) {
                int mt, nt;
                if (!tile_map256(bid, nblk, it, 8, mt, nt)) break;
                const int m0 = mt * 256, n0 = nt * 128;
                f32x16 acc2[2][4];
                gemm_tile256<false>(obuf + (size_t)m0 * 2048, 2048, w + (size_t)n0 * 2048, 2048, 2048, lds, acc2, tid);
                __syncthreads();
                char* stg = lds + wave * 8704;
#pragma unroll
                for (int hh = 0; hh < 2; ++hh) {
                    const int r0 = m0 + wave * 64 + hh * 32;
                    const size_t ob = (size_t)(r0 + 4 * hf) * DM + n0 + q;
                    float xv[16][4];
#pragma unroll
                    for (int i = 0; i < 16; ++i)
#pragma unroll
                        for (int j = 0; j < 4; ++j) xv[i][j] = __builtin_nontemporal_load(xin + ob + (size_t)((i & 3) + 8 * (i >> 2)) * DM + 32 * j);
#pragma unroll
                    for (int i = 0; i < 16; ++i) {
                        const int r = (i & 3) + 8 * (i >> 2);
                        float ss = 0.f;
#pragma unroll
                        for (int j = 0; j < 4; ++j) {
                            const float v = xv[i][j] + acc2[hh][j][i];
                            p.out[ob + (size_t)r * DM + 32 * j] = v;
                            *(h16*)(stg + (r + 4 * hf) * 272 + (32 * j + q) * 2) = (h16)v;
                            ss += v * v;
                        }
                        ss = half_sum(ss);
                        if (q == 0) atomicAdd(&rowss[r0 + r + 4 * hf], ss);
                    }
                    t_flush128(stg, xr + (size_t)r0 * DM + n0, DM, lane);
                }
            }
            { const int r7 = conv_matrix(p, 7, bid, nblk, (float*)lds, tid, 0); conv_matrix(p, 8, bid, nblk, (float*)lds, tid, r7); }
    }
    SYNC(5)
    if (RUN(7)) {
            IDS
            const h16* xn = (const h16*)(p.ws + OFF_XN1);
            const h16* w = (const h16*)(p.ws + OFF_WIN1);
            const float* rowss = (const float*)(p.ws + OFF_ROWSS);
            const int nper7 = nblk >> 3, full7 = (8 * 26) / nper7;
            for (int it = 0; it < full7; ++it) {
                int mt, nt;
                if (!tile_map256(bid, nblk, it, 26, mt, nt)) break;
                const int m0 = mt * 256, n0 = nt * 128;
                f32x16 acc2[2][4];
                gemm_tile256<true>(xn + (size_t)m0 * DM, DM, w + (size_t)n0 * DM, DM, DM, lds, acc2, tid);
                __syncthreads();
                char* stg = lds + wave * 8704;
                const size_t rw = (size_t)(m0 + wave * 64);
                {
                    const int mode = (nt < 6) ? 0 : (nt < 10 ? 1 : 2);
                    h16* dst = (nt < 4) ? (h16*)(p.ws + OFF_CQ) + rw * 512 + n0
                             : (nt < 6) ? (h16*)(p.ws + OFF_CKV) + rw * 256 + (n0 - 512)
                             : (nt < 10) ? (h16*)(p.ws + OFF_XQ1) + rw * 512 + (n0 - 768) : obuf + rw * 2048 + (n0 - 1280);
                    const int ld = (nt < 4) ? 512 : (nt < 6 ? 256 : (nt < 10 ? 512 : 2048));
#pragma unroll
                    for (int hh = 0; hh < 2; ++hh) {
                        const float pre = rsqrtf(rowss[rw + hh * 32 + q] * (1.f / DM) + EPS);
                        if (nt < 6) t_rowss(acc2[hh], pre, (float*)(p.ws + (nt < 4 ? OFF_ROWSS2 : OFF_ROWSS3)) + rw + hh * 32 + q, hf);
                        t_epi(acc2[hh], mode, p.xq_norm + 128, pre, stg, dst + (size_t)(hh * 32) * ld, ld, q, hf, lane);
                    }
                }
            }
            for (int st = (bid >> 3); st < 2 * (8 * 26 - full7 * nper7); st += nper7) {
                const int n = full7 * nper7 + (st >> 1), half = st & 1;
                const int mt = (bid & 7) * 8 + (n / (4 * 26)) * 4 + (n & 3), nt = (n >> 2) % 26;
                const int m0 = mt * 256 + half * 128, n0 = nt * 128;
                f32x16 acc[4];
                gemm_tile<true>(xn + (size_t)m0 * DM, DM, w + (size_t)n0 * DM, DM, DM, lds, acc, tid);
                __syncthreads();
                char* stg = lds + wave * 8704;
                const size_t rw = (size_t)(m0 + wave * 32);
                const int mode = (nt < 6) ? 0 : (nt < 10 ? 1 : 2);
                h16* dst = (nt < 4) ? (h16*)(p.ws + OFF_CQ) + rw * 512 + n0
                         : (nt < 6) ? (h16*)(p.ws + OFF_CKV) + rw * 256 + (n0 - 512)
                         : (nt < 10) ? (h16*)(p.ws + OFF_XQ1) + rw * 512 + (n0 - 768) : obuf + rw * 2048 + (n0 - 1280);
                const int ld = (nt < 4) ? 512 : (nt < 6 ? 256 : (nt < 10 ? 512 : 2048));
                const float pre = rsqrtf(rowss[rw + q] * (1.f / DM) + EPS);
                if (nt < 6) t_rowss(acc, pre, (float*)(p.ws + (nt < 4 ? OFF_ROWSS2 : OFF_ROWSS3)) + rw + q, hf);
                t_epi(acc, mode, p.xq_norm + 128, pre, stg, dst, ld, q, hf, lane);
            }
            for (int t2 = nblk - 1 - bid; t2 < 128; t2 += nblk) {
                f32x16 acc[4];
                const int m0 = t2 * 128;
                gemm_tile<true>(xn + (size_t)m0 * DM, DM, w + (size_t)(26 * 128) * DM, DM, DM, lds, acc, tid);
                const size_t row = (size_t)(m0 + wave * 32 + q);
                __syncthreads();
                char* stg = lds + wave * 8704;
                t_rope64(acc[0], acc[1], p.k_rope_norm, rsqrtf(rowss[row] * (1.f / DM) + EPS), (float)p.pos[row], (h16*)(stg + q * 272), hf);
                t_flush64(stg, (h16*)(p.ws + OFF_KR) + (size_t)(m0 + wave * 32) * 64, 64, lane);
            }
    }
    SYNC(7)
    if (RUN(8)) {
            IDS
            const h16* cq = (const h16*)(p.ws + OFF_CQ);
            const h16* w = (const h16*)(p.ws + OFF_WUQ);
            h16* Q = (h16*)(p.ws + OFF_Q);
            for (int it = 0;; ++it) {
                int mt, nt;
                if (!tile_map(bid, nblk, it, 18, mt, nt)) break;
                const int m0 = mt * 128;
                f32x16 acc[4];
                gemm_tile<true>(cq + (size_t)m0 * 512, 512, w + (size_t)(nt * 128) * 512, 512, 512, lds, acc, tid);
                const int b = m0 >> 11, l = (m0 & 2047) + wave * 32 + q;
                const float pre = rsqrtf(((const float*)(p.ws + OFF_ROWSS2))[m0 + wave * 32 + q] * (1.f / 512.f) + EPS);
                if (nt < 12) {
                    __syncthreads();
                    char* stg = lds + wave * 8704;
                    t_norm128(acc, pre, (h16*)(stg + q * 272), hf);
                    t_flush128g(stg, Q + ((size_t)(b * 12 + nt) * SEQ + (l - q)) * 192, 192, p.q_nope_norm, lane);
                } else {
                    const int hA = 2 * (nt - 12);
                    const float posf = (float)p.pos[m0 + wave * 32 + q];
                    __syncthreads();
                    char* stg = lds + wave * 8704;
                    t_rope64(acc[0], acc[1], p.q_rope_norm, pre, posf, (h16*)(stg + q * 272), hf);
                    t_flush64(stg, Q + ((size_t)(b * 12 + hA) * SEQ + (l - q)) * 192 + 128, 192, lane);
                    t_rope64(acc[2], acc[3], p.q_rope_norm, pre, posf, (h16*)(stg + q * 272), hf);
                    t_flush64(stg, Q + ((size_t)(b * 12 + hA + 1) * SEQ + (l - q)) * 192 + 128, 192, lane);
                }
            }
            mem_attn_phase(p, 1, ctr + 1, lds, tid);
    }
    SYNC(8)
    if (RUN(9)) {
            IDS
            const h16* ckv = (const h16*)(p.ws + OFF_CKV);
            const h16* w = (const h16*)(p.ws + OFF_WUKV);
            for (int it = 0;; ++it) {
                int mt, nt;
                if (!tile_map(bid, nblk, it, 24, mt, nt)) break;
                const int m0 = mt * 128, h = nt >> 1;
                f32x16 acc[4];
                const float* rss3 = (const float*)(p.ws + OFF_ROWSS3) + m0 + wave * 32;
                const int b = m0 >> 11, l0 = (m0 & 2047) + wave * 32;
                if ((nt & 1) == 0) {
                    gemm_tile<true>(ckv + (size_t)m0 * 256, 256, w + (size_t)(h * 256) * 256, 256, 256, lds, acc, tid);
                    h16* Kn = (h16*)(p.ws + OFF_KN);
                    __syncthreads();
                    char* stg = lds + wave * 8704;
                    t_norm128(acc, rsqrtf(rss3[q] * (1.f / 256.f) + EPS), (h16*)(stg + q * 272), hf);
                    t_flush128g(stg, Kn + ((size_t)(b * 12 + h) * SEQ + l0) * 128, 128, p.k_nope_norm, lane);
                } else {
                    gemm_tile<false>(ckv + (size_t)m0 * 256, 256, w + (size_t)(h * 256 + 128) * 256, 256, 256, lds, acc, tid);
                    __syncthreads();
                    {
                        char* img = lds + ((wave >> 1) * 128 + q) * 136 + ((wave & 1) * 32 + 4 * hf) * 2;
#pragma unroll
                        for (int g4 = 0; g4 < 4; ++g4) {
                            const float4 s4 = *(const float4*)(rss3 + 8 * g4 + 4 * hf);
                            float4 pr;
                            pr.x = rsqrtf(s4.x * (1.f / 256.f) + EPS); pr.y = rsqrtf(s4.y * (1.f / 256.f) + EPS);
                            pr.z = rsqrtf(s4.z * (1.f / 256.f) + EPS); pr.w = rsqrtf(s4.w * (1.f / 256.f) + EPS);
#pragma unroll
                            for (int j = 0; j < 4; ++j) {
                                h16x4 v;
                                v[0] = (h16)(acc[j][4 * g4 + 0] * pr.x); v[1] = (h16)(acc[j][4 * g4 + 1] * pr.y);
                                v[2] = (h16)(acc[j][4 * g4 + 2] * pr.z); v[3] = (h16)(acc[j][4 * g4 + 3] * pr.w);
                                *(h16x4*)(img + (32 * j) * 136 + 8 * g4 * 2) = v;
                            }
                        }
                    }
                    __syncthreads();
                    {
                        h16* Vt = (h16*)(p.ws + OFF_VT) + (size_t)(b * 12 + h) * 128 * SEQ + (size_t)((m0 & 2047) >> 6) * 8192;
#pragma unroll
                        for (int i = 0; i < 8; ++i) {
                            const int cidx = tid + 256 * i, row = cidx >> 3, c = cidx & 7;
                            *(h16x8*)(Vt + (size_t)row * 64 + c * 8) = *(const h16x8*)(lds + row * 136 + c * 16);
                        }
                    }
                }
            }
    }
    SYNC(9)
    if (RUN(10)) {
            IDS
            const h16* Q = (const h16*)(p.ws + OFF_Q);
            const h16* Kn = (const h16*)(p.ws + OFF_KN);
            const h16* Kr = (const h16*)(p.ws + OFF_KR);
            const h16* Vt = (const h16*)(p.ws + OFF_VT);
            volatile int* sitem = (volatile int*)(lds + LDS_ITEM);
            const float sc = 0.07216878364870322f * LOG2E;
            for (int rep = 0; rep < NREP(9); ++rep)
            for (;;) {
                __syncthreads();
                if (tid == 0) *sitem = atomicAdd(ctr + 2 + (NREP(9) - 1 - rep) * 4, 1);
                __syncthreads();
                const int it = *sitem;
                if (it >= 1536) break;
                const int qt = 15 - it / 96, bh = it % 96, b = bh / 12, h = bh % 12;
                const bool dummy = (rep + 1 < NREP(9));
                attn_item<192, true>(Q + ((size_t)bh * SEQ + qt * 128) * 192, 192, Kn + (size_t)bh * SEQ * 128, 128, Kr + (size_t)b * SEQ * 64,
                                     Vt + (size_t)bh * 128 * SEQ, 64, 8192, 2 * qt + 2, qt * 128,
                                     dummy ? (h16*)(p.ws + OFF_CKV) : obuf + ((size_t)b * SEQ + qt * 128) * 2048 + h * 128, dummy ? 0 : 2048, sc, lds, tid);
            }
    }
    SYNC(10)
    if (RUN(11)) {
            IDS
            const h16* w = (const h16*)(p.ws + OFF_WOUT1);
            const float* xin = p.out;
            for (int it = 0;; ++it) {
                int mt, nt;
                if (!tile_map256(bid, nblk, it, 8, mt, nt)) break;
                const int m0 = mt * 256, n0 = nt * 128;
                f32x16 acc2[2][4];
                gemm_tile256<false>(obuf + (size_t)m0 * 2048, 2048, w + (size_t)n0 * 2048, 2048, 2048, lds, acc2, tid);
#pragma unroll
                for (int hh = 0; hh < 2; ++hh) {
                    const size_t ob = (size_t)(m0 + wave * 64 + hh * 32 + 4 * hf) * DM + n0 + q;
                    float xv[16][4];
#pragma unroll
                    for (int i = 0; i < 16; ++i)
#pragma unroll
                        for (int j = 0; j < 4; ++j) xv[i][j] = __builtin_nontemporal_load(xin + ob + (size_t)((i & 3) + 8 * (i >> 2)) * DM + 32 * j);
#pragma unroll
                    for (int i = 0; i < 16; ++i)
#pragma unroll
                        for (int j = 0; j < 4; ++j) __builtin_nontemporal_store(xv[i][j] + acc2[hh][j][i], p.out + ob + (size_t)((i & 3) + 8 * (i >> 2)) * DM + 32 * j);
                }
            }
    }
}

extern "C" void kernel_launch(void* const* d_in, const int* in_sizes, int n_in, void* d_out, int out_size, void* d_ws, size_t ws_size,
                              hipStream_t stream) {
    static int grid = 0;
    if (!grid) {
        int dev = 0, cus = 0, per_cu = 0;
        hipGetDevice(&dev);
        hipDeviceGetAttribute(&cus, hipDeviceAttributeMultiprocessorCount, dev);
        hipOccupancyMaxActiveBlocksPerMultiprocessor(&per_cu, mega, 256, 0);
        if (per_cu < 1) per_cu = 1;
        if (per_cu > 2) per_cu = 2;
        grid = cus * per_cu;
    }
    P p{};
    p.x = (const float*)d_in[0]; p.mem = (const float*)d_in[1]; p.pos = (const int*)d_in[2];
    p.ln_gain = (const float*)d_in[3]; p.w_out = (const float*)d_in[4]; p.mem_norm = (const float*)d_in[5];
    p.w_mem_kv = (const float*)d_in[6]; p.xq_norm = (const float*)d_in[7]; p.xk_norm = (const float*)d_in[8];
    p.s5_w_in = (const float*)d_in[9]; p.lam_re = (const float*)d_in[10]; p.lam_im = (const float*)d_in[11];
    p.log_step = (const float*)d_in[12]; p.b_re = (const float*)d_in[13]; p.b_im = (const float*)d_in[14];
    p.c_re = (const float*)d_in[15]; p.c_im = (const float*)d_in[16]; p.s5_d = (const float*)d_in[17]; p.w_glu = (const float*)d_in[18];
    p.mla_w_in = (const float*)d_in[19]; p.q_lora_norm = (const float*)d_in[20]; p.kv_lora_norm = (const float*)d_in[21];
    p.w_uq = (const float*)d_in[22]; p.w_ukv = (const float*)d_in[23]; p.q_nope_norm = (const float*)d_in[24];
    p.k_nope_norm = (const float*)d_in[25]; p.q_rope_norm = (const float*)d_in[26]; p.k_rope_norm = (const float*)d_in[27];
    p.out = (float*)d_out; p.ws = (char*)d_ws;
    hipMemsetAsync(d_ws, 0, 32768, stream);
#if MULTI_LAUNCH
    for (int ph = 0; ph < 12; ++ph) hipLaunchKernelGGL(mega, dim3(grid), dim3(256), 0, stream, p, ph, ph + 1);
#else
    int lo = 0, hi = 12;
    void* args[] = {&p, &lo, &hi};
    hipError_t e = hipLaunchCooperativeKernel((void*)mega, dim3(grid), dim3(256), args, 0, stream);
    if (e != hipSuccess) fprintf(stderr, "cooperative launch failed: %s (grid %d)\n", hipGetErrorString(e), grid);
#endif
}
```

```cpp
#include <hip/hip_runtime.h>
#include <hip/hip_fp16.h>
#include <hip/hip_cooperative_groups.h>
#include <cstdio>
namespace cg = cooperative_groups;

#ifndef PHMASK
#define PHMASK 0x7ff
#endif
#define PHEN(k) ((PHMASK >> (k)) & 1)
#ifndef DUPMASK
#define DUPMASK 0
#endif
#define NREP(k) (((DUPMASK >> (k)) & 1) ? 2 : 1)
#ifndef MULTI_LAUNCH
#define MULTI_LAUNCH 0
#endif

typedef _Float16 h16;
typedef h16 h16x8 __attribute__((ext_vector_type(8)));
typedef h16 h16x4 __attribute__((ext_vector_type(4)));
typedef float f32x16 __attribute__((ext_vector_type(16)));
typedef float f32x4 __attribute__((ext_vector_type(4)));
__device__ __forceinline__ float4 nt_load4(const float* p) { const f32x4 v = __builtin_nontemporal_load((const f32x4*)p); return make_float4(v[0], v[1], v[2], v[3]); }
#define MFMA16(a, b, c) __builtin_amdgcn_mfma_f32_16x16x32_f16((a), (b), (c), 0, 0, 0)
#define DI __device__ __forceinline__
#define MFMA32(a, b, c) __builtin_amdgcn_mfma_f32_32x32x16_f16((a), (b), (c), 0, 0, 0)

constexpr int SEQ = 2048, NB = 8, TOK = NB * SEQ, DM = 1024;
constexpr float EPS = 1e-6f;
constexpr float LOG2E = 1.4426950408889634f;

constexpr size_t MiB = (size_t)1 << 20;
constexpr size_t OFF_CTR = 0;
constexpr size_t OFF_BAR = 16 * 1024;
constexpr size_t OFF_S5A = 64 * 1024;
constexpr size_t OFF_S5B = 128 * 1024;
constexpr size_t OFF_S5C = 512 * 1024;
constexpr size_t OFF_S5STEP = 1280 * 1024;
constexpr size_t OFF_ROWSS2 = 1472 * 1024;
constexpr size_t OFF_ROWSS3 = 1536 * 1024;
constexpr size_t OFF_ROWSS = 1408 * 1024;
constexpr size_t OFF_S5A128 = 1344 * 1024;
constexpr size_t OFF_S5E = 214 * ((size_t)1 << 20);
constexpr size_t OFF_KR = 2 * MiB;
constexpr size_t OFF_WOUT1 = 4 * MiB;
constexpr size_t OFF_OBUF = 8 * MiB;
constexpr size_t OFF_WIN0 = 72 * MiB;
constexpr size_t OFF_WGLU = 80 * MiB;
constexpr size_t OFF_WOUT0 = 89 * MiB;
constexpr size_t OFF_WMKV0 = 93 * MiB;
constexpr size_t OFF_WMKV1 = 95 * MiB;
constexpr size_t OFF_MEMK0 = 97 * MiB;
constexpr size_t OFF_MEMVT0 = 99 * MiB;
constexpr size_t OFF_U = 101 * MiB;
constexpr size_t OFF_XQ0 = 149 * MiB;
constexpr size_t OFF_XN0 = 165 * MiB;
constexpr size_t OFF_MEMN0 = 197 * MiB;
constexpr size_t OFF_MEMN1 = 201 * MiB;
constexpr size_t OFF_YG = 165 * MiB;
constexpr size_t OFF_MEMK1 = 250 * MiB;
constexpr size_t OFF_MEMVT1 = 252 * MiB;
constexpr size_t OFF_XN1 = 112 * MiB;
constexpr size_t OFF_WIN1 = 104 * MiB;
constexpr size_t OFF_Q = 72 * MiB;
constexpr size_t OFF_KN = 144 * MiB;
constexpr size_t OFF_VT = 192 * MiB;
constexpr size_t OFF_CQ = 144 * MiB;
constexpr size_t OFF_XQ1 = 160 * MiB;
constexpr size_t OFF_WUQ = 176 * MiB;
constexpr size_t OFF_CKV = 240 * MiB;
constexpr size_t OFF_WUKV = 248 * MiB;

constexpr int LDS_BYTES = 73728 + 1024;
constexpr int LDS_XB = 73728 + 768;
constexpr int LDS_RS = 73728;
constexpr int LDS_ITEM = 73728 + 512;

struct P {
    const float* x; const float* mem; const int* pos;
    const float* ln_gain; const float* w_out; const float* mem_norm; const float* w_mem_kv; const float* xq_norm; const float* xk_norm;
    const float* s5_w_in; const float* lam_re; const float* lam_im; const float* log_step;
    const float* b_re; const float* b_im; const float* c_re; const float* c_im; const float* s5_d; const float* w_glu;
    const float* mla_w_in; const float* q_lora_norm; const float* kv_lora_norm; const float* w_uq; const float* w_ukv;
    const float* q_nope_norm; const float* k_nope_norm; const float* q_rope_norm; const float* k_rope_norm;
    float* out; char* ws;
};

DI float wave_sum(float v) {
    v += __shfl_xor(v, 32); v += __shfl_xor(v, 16); v += __shfl_xor(v, 8);
    v += __shfl_xor(v, 4); v += __shfl_xor(v, 2); v += __shfl_xor(v, 1);
    return v;
}
DI float half_sum(float v) {
    v += __shfl_xor(v, 16); v += __shfl_xor(v, 8); v += __shfl_xor(v, 4); v += __shfl_xor(v, 2); v += __shfl_xor(v, 1);
    return v;
}
DI int crow(int i, int hf) { return (i & 3) + 8 * (i >> 2) + 4 * hf; }
DI int swap23(int m) { return (m & 0x13) | ((m & 4) << 1) | ((m & 8) >> 1); }
DI float sigmoidf_(float x) { return __builtin_amdgcn_rcpf(1.f + __expf(-x)); }
DI float siluf_(float x) { return x * sigmoidf_(x); }
DI float geluf_(float x) {
    const float z2 = 1.5957691216057308f * x * fmaf(0.044715f * x, x, 1.f);
    return x * __builtin_amdgcn_rcpf(1.f + __expf(-z2));
}

DI void rmsnorm_rows(const float* __restrict__ src, const float* __restrict__ gain, h16* __restrict__ dst, int nrows,
                     int wgid, int nw, int lane) {
    float4 v[4], vn[4];
    int r = wgid;
    if (r < nrows) {
#pragma unroll
        for (int i = 0; i < 4; ++i) v[i] = nt_load4(src + (size_t)r * DM + (lane + 64 * i) * 4);
    }
    for (; r < nrows; r += nw) {
        const int rn = r + nw;
        if (rn < nrows) {
#pragma unroll
            for (int i = 0; i < 4; ++i) vn[i] = nt_load4(src + (size_t)rn * DM + (lane + 64 * i) * 4);
        }
        float ss = 0.f;
#pragma unroll
        for (int i = 0; i < 4; ++i) ss += v[i].x * v[i].x + v[i].y * v[i].y + v[i].z * v[i].z + v[i].w * v[i].w;
        ss = wave_sum(ss);
        float rs = rsqrtf(ss * (1.f / DM) + EPS);
#pragma unroll
        for (int i = 0; i < 4; ++i) {
            float4 g = ((const float4*)gain)[lane + 64 * i];
            h16x4 o; o[0] = (h16)(v[i].x * rs * g.x); o[1] = (h16)(v[i].y * rs * g.y); o[2] = (h16)(v[i].z * rs * g.z); o[3] = (h16)(v[i].w * rs * g.w);
            *(h16x4*)(dst + (size_t)r * DM + (lane + 64 * i) * 4) = o;
        }
#pragma unroll
        for (int i = 0; i < 4; ++i) v[i] = vn[i];
    }
}

DI void conv_tile(const float* __restrict__ src, int Nsrc, int srccol0, h16* __restrict__ dst, int K, int dstrow0, int k0,
                  const float* __restrict__ kgain, float* tile, int tid) {
    __syncthreads();
    if (srccol0 >= 0) {
#pragma unroll
        for (int i = 0; i < 4; ++i) {
            int k = (tid >> 4) + 16 * i, n = (tid & 15) * 4;
            float4 v = nt_load4(src + (size_t)(k0 + k) * Nsrc + srccol0 + n);
            float g = kgain ? kgain[k0 + k] : 1.f;
            tile[k * 65 + n + 0] = v.x * g; tile[k * 65 + n + 1] = v.y * g; tile[k * 65 + n + 2] = v.z * g; tile[k * 65 + n + 3] = v.w * g;
        }
    }
    __syncthreads();
#pragma unroll
    for (int i = 0; i < 2; ++i) {
        int c = tid + 256 * i, n = c >> 3, kc = c & 7;
        h16x8 o;
#pragma unroll
        for (int e = 0; e < 8; ++e) o[e] = (srccol0 >= 0) ? (h16)tile[(kc * 8 + e) * 65 + n] : (h16)0.f;
        *(h16x8*)(dst + (size_t)(dstrow0 + n) * K + k0 + kc * 8) = o;
    }
}

DI int conv_matrix(const P& p, int mat, int bid, int nblk, float* tile, int tid, int rot = 0) {
    const float* src; int Nsrc, K, Nd; h16* dst; const float* kg = nullptr;
    switch (mat) {
        case 0: src = p.s5_w_in; Nsrc = 4096; K = 1024; Nd = 4096; dst = (h16*)(p.ws + OFF_WIN0); break;
        case 1: src = p.w_glu; Nsrc = 3072; K = 1536; Nd = 3072; dst = (h16*)(p.ws + OFF_WGLU); break;
        case 2: src = p.w_out; Nsrc = 1024; K = 2048; Nd = 1024; dst = (h16*)(p.ws + OFF_WOUT0); break;
        case 3: src = p.w_out + (size_t)2048 * 1024; Nsrc = 1024; K = 2048; Nd = 1024; dst = (h16*)(p.ws + OFF_WOUT1); break;
        case 4: src = p.w_mem_kv; Nsrc = 1024; K = 1024; Nd = 1024; dst = (h16*)(p.ws + OFF_WMKV0); break;
        case 5: src = p.w_mem_kv + (size_t)1024 * 1024; Nsrc = 1024; K = 1024; Nd = 1024; dst = (h16*)(p.ws + OFF_WMKV1); break;
        case 6: src = p.w_ukv; Nsrc = 3072; K = 256; Nd = 3072; dst = (h16*)(p.ws + OFF_WUKV); kg = p.kv_lora_norm; break;
        case 7: src = p.mla_w_in; Nsrc = 3392; K = 1024; Nd = 3456; dst = (h16*)(p.ws + OFF_WIN1); kg = p.ln_gain + DM; break;
        default: src = p.w_uq; Nsrc = 2304; K = 512; Nd = 2304; dst = (h16*)(p.ws + OFF_WUQ); kg = p.q_lora_norm; break;
    }
    const int nkt = K / 64, nitems = (Nd / 64) * nkt;
    for (int it = (bid + nblk - rot % nblk) % nblk; it < nitems; it += nblk) {
        int nt = it / nkt, kt = it % nkt;
        int n0 = nt * 64, sc = n0;
        if (mat == 1) { int t128 = n0 >> 7, half = (n0 >> 6) & 1; sc = (half ? 1536 : 0) + t128 * 64; }
        else if (mat == 7) {
            if (n0 < 768) sc = n0;
            else if (n0 < 1280) sc = 832 + (n0 - 768);
            else if (n0 < 3328) sc = 1344 + (n0 - 1280);
            else if (n0 < 3392) sc = 768 + (n0 - 3328);
            else sc = -1;
        } else if (mat == 8) {
            if (n0 < 1536) { int h = n0 >> 7; sc = h * 192 + (n0 & 127); }
            else { int h = (n0 - 1536) >> 6; sc = h * 192 + 128; }
        }
        conv_tile(src, Nsrc, sc, dst, K, n0, kt * 64, kg, tile, tid);
    }
    return nitems;
}

DI void s5_tables(const P& p, int gtid, int nthreads) {
    float* At = (float*)(p.ws + OFF_S5A);
    h16* Bt = (h16*)(p.ws + OFF_S5B);
    h16* Ct = (h16*)(p.ws + OFF_S5C);
    float* St = (float*)(p.ws + OFF_S5STEP);
    for (int idx2 = gtid; idx2 < 96 * 64 * 16; idx2 += nthreads) {
        const int idx = idx2 >> 4, c = idx2 & 15;
        const int g = idx >> 6, pp = idx & 63;
        const float step = expf(p.log_step[g]);
        const float lr = p.lam_re[idx], li = p.lam_im[idx];
        const float xr = lr * step, yi = li * step;
        float sy, cy; sincosf(yi, &sy, &cy);
        const float ex = expf(xr);
        const float are = ex * cy, aim = ex * sy;
        const float sh = sinf(0.5f * yi);
        const float nre = expm1f(xr) * cy - 2.f * sh * sh;
        const float nim = aim;
        const float den = (lr * lr + li * li) * step;
        const float cre = (nre * lr + nim * li) / den;
        const float cim = (nim * lr - nre * li) / den;
        if (c == 0) {
            At[idx * 2] = are; At[idx * 2 + 1] = aim;
            float s128, c128; sincosf(128.f * yi, &s128, &c128);
            const float e128 = expf(128.f * xr);
            float* A128 = (float*)(p.ws + OFF_S5A128);
            A128[idx * 2] = e128 * c128; A128[idx * 2 + 1] = e128 * s128;
            if (pp == 0) St[g] = step;
        }
        const int q = pp & 31, jj = pp >> 5;
        const float br = p.b_re[(size_t)idx * 16 + c], bi = p.b_im[(size_t)idx * 16 + c];
        Bt[((size_t)g * 128 + 32 * jj + q) * 16 + c] = (h16)(cre * br - cim * bi);
        Bt[((size_t)g * 128 + 32 * (2 + jj) + q) * 16 + c] = (h16)(cre * bi + cim * br);
        const float cs = step * 1024.f;
        const float cr = p.c_re[((size_t)g * 16 + c) * 64 + pp], ci = p.c_im[((size_t)g * 16 + c) * 64 + pp];
        Ct[((size_t)g * 16 + c) * 128 + 4 * q + jj] = (h16)(cr * cs);
        Ct[((size_t)g * 16 + c) * 128 + 4 * q + 2 + jj] = (h16)(-ci * cs);
    }
}

template <bool SWAP>
DI void gemm_tile(const h16* __restrict__ A, int lda, const h16* __restrict__ B, int ldb, int K, char* lds, f32x16 (&acc)[4], int tid) {
    const int lane = tid & 63, wave = __builtin_amdgcn_readfirstlane(tid >> 6), q = lane & 31, hf = lane >> 5;
#pragma unroll
    for (int j = 0; j < 4; ++j)
#pragma unroll
        for (int i = 0; i < 16; ++i) acc[j][i] = 0.f;
    const int nk = K >> 6;
    const h16* src[8];
    {
        const int rl = lane >> 3;
#pragma unroll
        for (int i = 0; i < 8; ++i) {
            const int r = 8 * (wave * 8 + i) + rl;
            const int c = (lane & 7) ^ ((4 * (i & 1) + (lane >> 4)) & 7);
            src[i] = (r < 128) ? A + (size_t)r * lda + c * 8 : B + (size_t)(r - 128) * ldb + c * 8;
        }
    }
    const int xs = (q >> 1) & 7;
    int fo[4];
#pragma unroll
    for (int kk = 0; kk < 4; ++kk) fo[kk] = q * 128 + (((kk * 2 + hf) ^ xs) << 4);
#define G_GLDS(stage_, k0_)                                                                                           \
    _Pragma("unroll") for (int i = 0; i < 8; ++i)                                                                     \
        __builtin_amdgcn_global_load_lds((const unsigned*)(src[i] + (k0_)), (unsigned*)(lds + (stage_) * 32768 + (wave * 8 + i) * 1024), 16, 0, 0);
#define G_FRAG(buf_, kk_, FA, FB)                                                                                     \
    FA = *(const h16x8*)(lds + (buf_) * 32768 + wave * (32 * 128) + fo[kk_]);                                         \
    _Pragma("unroll") for (int j = 0; j < 4; ++j)                                                                     \
        FB[j] = *(const h16x8*)(lds + (buf_) * 32768 + 16384 + j * (32 * 128) + fo[kk_]);
#define G_MMA(FA, FB) _Pragma("unroll") for (int j = 0; j < 4; ++j) acc[j] = SWAP ? MFMA32(FB[j], FA, acc[j]) : MFMA32(FA, FB[j], acc[j]);
#define G_STEP(buf_, kload_)                                                                                          \
    {                                                                                                                 \
        h16x8 fa0, fb0[4], fa1, fb1[4];                                                                               \
        asm volatile("s_waitcnt vmcnt(0)" ::: "memory");                                                              \
        __syncthreads();                                                                                              \
        G_GLDS((buf_) ^ 1, kload_);                                                                                   \
        G_FRAG(buf_, 0, fa0, fb0);                                                                                    \
        G_FRAG(buf_, 1, fa1, fb1);                                                                                    \
        __builtin_amdgcn_sched_barrier(0);                                                                            \
        G_MMA(fa0, fb0);                                                                                              \
        __builtin_amdgcn_sched_barrier(0);                                                                            \
        G_FRAG(buf_, 2, fa0, fb0);                                                                                    \
        __builtin_amdgcn_sched_barrier(0);                                                                            \
        G_MMA(fa1, fb1);                                                                                              \
        __builtin_amdgcn_sched_barrier(0);                                                                            \
        G_FRAG(buf_, 3, fa1, fb1);                                                                                    \
        __builtin_amdgcn_sched_barrier(0);                                                                            \
        G_MMA(fa0, fb0);                                                                                              \
        G_MMA(fa1, fb1);                                                                                              \
    }
    __syncthreads();
    G_GLDS(0, 0);
    const int klast = (nk - 1) << 6;
    for (int kt = 0; kt < nk; kt += 2) {
        { const int k0 = min((kt + 1) << 6, klast); G_STEP(0, k0); }
        { const int k1 = min((kt + 2) << 6, klast); G_STEP(1, k1); }
    }
    asm volatile("s_waitcnt vmcnt(0)" ::: "memory");
#undef G_GLDS
#undef G_FRAG
#undef G_MMA
#undef G_STEP
}

template <bool SWAP, bool AGM = false>
DI void gemm_tile256(const h16* __restrict__ A, int lda, const h16* __restrict__ B, int ldb, int K, char* lds, f32x16 (&acc)[2][4], int tid) {
    const int lane = tid & 63, wave = __builtin_amdgcn_readfirstlane(tid >> 6), q = lane & 31, hf = lane >> 5;
#pragma unroll
    for (int hh = 0; hh < 2; ++hh)
#pragma unroll
        for (int j = 0; j < 4; ++j)
#pragma unroll
            for (int i = 0; i < 16; ++i) acc[hh][j][i] = 0.f;
    const int nk = K >> 5;
    const h16* src[6];
    {
        const int rl = lane >> 2, c = (lane & 3) ^ ((lane >> 4) & 3);
#pragma unroll
        for (int i = 0; i < 6; ++i) {
            const int r = 16 * (wave * 6 + i) + rl;
            if (AGM) src[i] = (r < 256) ? A + (size_t)(c >> 1) * TOK * 16 + (size_t)r * 16 + 8 * (c & 1) : B + (size_t)(r - 256) * ldb + c * 8;
            else src[i] = (r < 256) ? A + (size_t)r * lda + c * 8 : B + (size_t)(r - 256) * ldb + c * 8;
        }
    }
#define T_KOFF(i_, k0_) ((AGM && (16 * (wave * 6 + (i_)) < 256)) ? (size_t)(k0_) * TOK : (size_t)(k0_))
    const int xs = (q >> 2) & 3;
    const int fo0 = q * 64 + ((hf ^ xs) << 4), fo1 = q * 64 + (((2 + hf) ^ xs) << 4);
#define T_GLDS(stage_, k0_)                                                                                           \
    _Pragma("unroll") for (int i = 0; i < 6; ++i)                                                                     \
        __builtin_amdgcn_global_load_lds((const unsigned*)(src[i] + T_KOFF(i, k0_)), (unsigned*)(lds + (stage_) * 24576 + (wave * 6 + i) * 1024), 16, 0, 0);
#define T_STEP(buf_, kload_)                                                                                          \
    {                                                                                                                 \
        h16x8 fa[2][2], fb[2][4];                                                                                     \
        asm volatile("s_waitcnt vmcnt(0)" ::: "memory");                                                              \
        __syncthreads();                                                                                              \
        _Pragma("unroll") for (int hh = 0; hh < 2; ++hh) fa[0][hh] = *(const h16x8*)(lds + (buf_) * 24576 + (wave * 64 + hh * 32) * 64 + fo0); \
        _Pragma("unroll") for (int j = 0; j < 4; ++j) fb[0][j] = *(const h16x8*)(lds + (buf_) * 24576 + 16384 + (j * 32) * 64 + fo0); \
        __builtin_amdgcn_sched_barrier(0);                                                                            \
        T_GLDS((buf_) ^ 1, kload_);                                                                                   \
        _Pragma("unroll") for (int hh = 0; hh < 2; ++hh) fa[1][hh] = *(const h16x8*)(lds + (buf_) * 24576 + (wave * 64 + hh * 32) * 64 + fo1); \
        _Pragma("unroll") for (int j = 0; j < 4; ++j) fb[1][j] = *(const h16x8*)(lds + (buf_) * 24576 + 16384 + (j * 32) * 64 + fo1); \
        _Pragma("unroll") for (int kk = 0; kk < 2; ++kk)                                                              \
            _Pragma("unroll") for (int hh = 0; hh < 2; ++hh)                                                          \
                _Pragma("unroll") for (int j = 0; j < 4; ++j) acc[hh][j] = SWAP ? MFMA32(fb[kk][j], fa[kk][hh], acc[hh][j]) : MFMA32(fa[kk][hh], fb[kk][j], acc[hh][j]); \
    }
    __syncthreads();
    T_GLDS(0, 0);
    const int klast = (nk - 1) << 5;
    for (int kt = 0; kt < nk; kt += 2) {
        { const int k0 = min((kt + 1) << 5, klast); T_STEP(0, k0); }
        { const int k1 = min((kt + 2) << 5, klast); T_STEP(1, k1); }
    }
    asm volatile("s_waitcnt vmcnt(0)" ::: "memory");
#undef T_GLDS
#undef T_STEP
#undef T_KOFF
}
DI bool tile_map256(int bid, int nblk, int it, int NT, int& mt, int& nt) {
    const int x = bid & 7, li = bid >> 3, nper = nblk >> 3;
    const int n = li + it * nper;
    if (n >= 8 * NT) return false;
    mt = x * 8 + (n / (4 * NT)) * 4 + (n & 3);
    nt = (n >> 2) % NT;
    return true;
}

DI void row_scales(const h16* __restrict__ A, int K, int m0, char* lds, int tid) {
    __syncthreads();
    const int row = tid >> 1, half = tid & 1, n = K >> 1;
    const h16* ap = A + (size_t)(m0 + row) * K + half * n;
    float ss = 0.f;
    for (int c = 0; c < n; c += 8) {
        h16x8 v = *(const h16x8*)(ap + c);
#pragma unroll
        for (int e = 0; e < 8; ++e) { float f = (float)v[e]; ss += f * f; }
    }
    ss += __shfl_xor(ss, 1);
    if (half == 0) ((float*)(lds + LDS_RS))[row] = rsqrtf(ss / (float)K + EPS);
    __syncthreads();
}

DI void epi_store(const f32x16 (&acc)[4], h16* __restrict__ dst, int ld, int mrow0, int col0, int q, int hf) {
#pragma unroll
    for (int i = 0; i < 16; ++i) {
        h16* rp = dst + (size_t)(mrow0 + crow(i, hf)) * ld + col0 + q;
#pragma unroll
        for (int j = 0; j < 4; ++j) rp[32 * j] = (h16)acc[j][i];
    }
}
DI void epi_norm128(const f32x16 (&acc)[4], const float* __restrict__ gain, const float* rs, int rsrow0, h16* __restrict__ dst, size_t rowstride,
                    int q, int hf) {
    float g[4];
#pragma unroll
    for (int j = 0; j < 4; ++j) g[j] = gain[32 * j + q];
    const float* rsb = rs ? rs + rsrow0 + 4 * hf : nullptr;
    dst += (size_t)(4 * hf) * rowstride;
#pragma unroll
    for (int i = 0; i < 16; ++i) {
        const int r = (i & 3) + 8 * (i >> 2);
        const float pre = rsb ? rsb[r] : 1.f;
        float v[4]; float ss = 0.f;
#pragma unroll
        for (int j = 0; j < 4; ++j) { v[j] = acc[j][i] * pre; ss += v[j] * v[j]; }
        ss = half_sum(ss);
        const float sc = rsqrtf(ss * (1.f / 128.f) + EPS);
        h16* rp = dst + (size_t)r * rowstride + q;
#pragma unroll
        for (int j = 0; j < 4; ++j) rp[32 * j] = (h16)(v[j] * sc * g[j]);
    }
}

DI void fast_sincos(float x, float& s, float& c) {
    const float k = rintf(x * 0.15915494309189535f);
    float r = fmaf(-k, 6.28125f, x);
    r = fmaf(-k, 0.0019353071795864769f, r);
    s = __sinf(r); c = __cosf(r);
}
DI void t_store(const f32x16 (&acc)[4], h16* __restrict__ rowp, int hf, float pre) {
#pragma unroll
    for (int j = 0; j < 4; ++j)
#pragma unroll
        for (int g4 = 0; g4 < 4; ++g4) {
            h16x4 v;
#pragma unroll
            for (int e = 0; e < 4; ++e) v[e] = (h16)(acc[j][4 * g4 + e] * pre);
            *(h16x4*)(rowp + 32 * j + 8 * g4 + 4 * hf) = v;
        }
}
DI void t_silu_store(const f32x16 (&acc)[4], h16* __restrict__ rowp, int hf) {
#pragma unroll
    for (int j = 0; j < 4; ++j)
#pragma unroll
        for (int g4 = 0; g4 < 4; ++g4) {
            h16x4 v;
#pragma unroll
            for (int e = 0; e < 4; ++e) v[e] = (h16)siluf_(acc[j][4 * g4 + e]);
            *(h16x4*)(rowp + 32 * j + 8 * g4 + 4 * hf) = v;
        }
}
DI void t_norm128(const f32x16 (&acc)[4], float pre, h16* __restrict__ rowp, int hf) {
    float ss = 0.f;
#pragma unroll
    for (int j = 0; j < 4; ++j)
#pragma unroll
        for (int i = 0; i < 16; ++i) { const float v = acc[j][i] * pre; ss += v * v; }
    ss += __shfl_xor(ss, 32);
    const float sc = rsqrtf(ss * (1.f / 128.f) + EPS) * pre;
    t_store(acc, rowp, hf, sc);
}
DI void wave_lds_fence() {
    asm volatile("s_waitcnt lgkmcnt(0)" ::: "memory");
    __builtin_amdgcn_wave_barrier();
}
DI void t_flush128(const char* stg, h16* __restrict__ dst, int ld, int lane) {
    wave_lds_fence();
#pragma unroll
    for (int r4 = 0; r4 < 8; ++r4) {
        const int row = 4 * r4 + (lane >> 4), c = lane & 15;
        const h16x8 x = *(const h16x8*)(stg + row * 272 + c * 16);
        *(h16x8*)(dst + (size_t)row * ld + c * 8) = x;
    }
    wave_lds_fence();
}
DI void t_flush128g(const char* stg, h16* __restrict__ dst, int ld, const float* __restrict__ gain, int lane) {
    wave_lds_fence();
    const int c = lane & 15;
    const float4 g0 = *(const float4*)(gain + c * 8), g1 = *(const float4*)(gain + c * 8 + 4);
#pragma unroll
    for (int r4 = 0; r4 < 8; ++r4) {
        const int row = 4 * r4 + (lane >> 4);
        const h16x8 x = *(const h16x8*)(stg + row * 272 + c * 16);
        h16x8 o;
        o[0] = (h16)((float)x[0] * g0.x); o[1] = (h16)((float)x[1] * g0.y); o[2] = (h16)((float)x[2] * g0.z); o[3] = (h16)((float)x[3] * g0.w);
        o[4] = (h16)((float)x[4] * g1.x); o[5] = (h16)((float)x[5] * g1.y); o[6] = (h16)((float)x[6] * g1.z); o[7] = (h16)((float)x[7] * g1.w);
        *(h16x8*)(dst + (size_t)row * ld + c * 8) = o;
    }
    wave_lds_fence();
}
DI void t_flush128_mul(const char* stg, h16* __restrict__ dst, int ld, int lane) {
    wave_lds_fence();
    const int c = lane & 15;
    h16x8 sg[8];
#pragma unroll
    for (int r4 = 0; r4 < 8; ++r4) sg[r4] = *(const h16x8*)(dst + (size_t)(4 * r4 + (lane >> 4)) * ld + c * 8);
#pragma unroll
    for (int r4 = 0; r4 < 8; ++r4) {
        const int row = 4 * r4 + (lane >> 4);
        const h16x8 x = *(const h16x8*)(stg + row * 272 + c * 16);
        h16x8 o;
#pragma unroll
        for (int e = 0; e < 8; ++e) o[e] = (h16)((float)x[e] * (float)sg[r4][e]);
        *(h16x8*)(dst + (size_t)row * ld + c * 8) = o;
    }
    wave_lds_fence();
}
DI void t_flush64(const char* stg, h16* __restrict__ dst, int ld, int lane) {
    wave_lds_fence();
#pragma unroll
    for (int r4 = 0; r4 < 4; ++r4) {
        const int row = 8 * r4 + (lane >> 3), c = lane & 7;
        const h16x8 x = *(const h16x8*)(stg + row * 272 + c * 16);
        *(h16x8*)(dst + (size_t)row * ld + c * 8) = x;
    }
    wave_lds_fence();
}
DI void t_flush64_mul(const char* stg, h16* __restrict__ dst, int ld, int lane) {
    wave_lds_fence();
    h16x8 sg[4];
#pragma unroll
    for (int r4 = 0; r4 < 4; ++r4) sg[r4] = *(const h16x8*)(dst + (size_t)(8 * r4 + (lane >> 3)) * ld + (lane & 7) * 8);
#pragma unroll
    for (int r4 = 0; r4 < 4; ++r4) {
        const int row = 8 * r4 + (lane >> 3), c = lane & 7;
        const h16x8 x = *(const h16x8*)(stg + row * 272 + c * 16);
        h16x8 o;
#pragma unroll
        for (int e = 0; e < 8; ++e) o[e] = (h16)((float)x[e] * (float)sg[r4][e]);
        *(h16x8*)(dst + (size_t)row * ld + c * 8) = o;
    }
    wave_lds_fence();
}
DI void t_flush_gm(const char* stg, h16* __restrict__ dst  , int lane) {
    wave_lds_fence();
    const int row = lane >> 1, half = lane & 1;
#pragma unroll
    for (int k = 0; k < 8; ++k) {
        const h16x8 x = *(const h16x8*)(stg + row * 272 + k * 32 + half * 16);
        *(h16x8*)(dst + (size_t)k * TOK * 16 + row * 16 + half * 8) = x;
    }
    wave_lds_fence();
}
DI void t_rowss(const f32x16 (&acc)[4], float pre, float* __restrict__ ssum_tok, int hf) {
    float ss = 0.f;
#pragma unroll
    for (int j = 0; j < 4; ++j)
#pragma unroll
        for (int i = 0; i < 16; ++i) { const float v = acc[j][i] * pre; ss += v * v; }
    ss += __shfl_xor(ss, 32);
    if (hf == 0) atomicAdd(ssum_tok, ss);
}
DI void t_epi(const f32x16 (&acc)[4], int mode, const float* gain, float pre, char* stg, h16* __restrict__ dst, int ld, int q, int hf, int lane) {
    float sc = pre;
    if (mode == 1) {
        float ss = 0.f;
#pragma unroll
        for (int j = 0; j < 4; ++j)
#pragma unroll
            for (int i = 0; i < 16; ++i) { const float v = acc[j][i] * pre; ss += v * v; }
        ss += __shfl_xor(ss, 32);
        sc = rsqrtf(ss * (1.f / 128.f) + EPS) * pre;
    }
    h16* srow = (h16*)(stg + q * 272) + 4 * hf;
#pragma unroll
    for (int j = 0; j < 4; ++j)
#pragma unroll
        for (int g4 = 0; g4 < 4; ++g4) {
            h16x4 v;
            if (mode == 2) {
#pragma unroll
                for (int e = 0; e < 4; ++e) v[e] = (h16)siluf_(acc[j][4 * g4 + e] * pre);
            } else {
#pragma unroll
                for (int e = 0; e < 4; ++e) v[e] = (h16)(acc[j][4 * g4 + e] * sc);
            }
            *(h16x4*)(srow + 32 * j + 8 * g4) = v;
        }
    if (mode == 1) t_flush128g(stg, dst, ld, gain, lane);
    else if (ld == 0) t_flush_gm(stg, dst, lane);
    else t_flush128(stg, dst, ld, lane);
}
DI void t_rope64(const f32x16& a0, const f32x16& a1, const float* __restrict__ gain, float pre, float posf, h16* __restrict__ rowp, int hf) {
    float ss = 0.f;
#pragma unroll
    for (int i = 0; i < 16; ++i) { const float v0 = a0[i] * pre, v1 = a1[i] * pre; ss += v0 * v0 + v1 * v1; }
    ss += __shfl_xor(ss, 32);
    const float sc = rsqrtf(ss * (1.f / 64.f) + EPS) * pre;
#pragma unroll
    for (int g4 = 0; g4 < 4; ++g4) {
        h16x4 o1, o2;
#pragma unroll
        for (int e = 0; e < 4; ++e) {
            const int d = 8 * g4 + 4 * hf + e;
            const float invf = exp2f(-(float)d * 0.41524101186092029f);
            float sn, cs; fast_sincos(posf * invf, sn, cs);
            const float x1 = a0[4 * g4 + e] * sc * gain[d], x2 = a1[4 * g4 + e] * sc * gain[32 + d];
            o1[e] = (h16)(x1 * cs - x2 * sn); o2[e] = (h16)(x1 * sn + x2 * cs);
        }
        *(h16x4*)(rowp + 8 * g4 + 4 * hf) = o1;
        *(h16x4*)(rowp + 32 + 8 * g4 + 4 * hf) = o2;
    }
}

template <int DK, bool CAUSAL>
DI void attn_item(const h16* __restrict__ Qb, int qstride, const h16* __restrict__ Kn, int knstride, const h16* __restrict__ Kr,
                  const h16* __restrict__ Vt, int vtstride, int vtile, int nkt, int q0, h16* __restrict__ outb, int ostride, float sc,
                  char* lds, int tid) {
    constexpr int KSTR = (DK + 8) * 2;
    constexpr int CPK = DK / 8;
    constexpr int NKC = 64 * CPK / 256;
    constexpr int NKS = DK / 16;
    char* Ks = lds; char* Vs = lds + 64 * KSTR;
    const int lane = tid & 63, wave = __builtin_amdgcn_readfirstlane(tid >> 6), q = lane & 31, hf = lane >> 5;
    h16x8 qf[NKS];
#pragma unroll
    for (int ks = 0; ks < NKS; ++ks) qf[ks] = *(const h16x8*)(Qb + (size_t)(wave * 32 + q) * qstride + 16 * ks + 8 * hf);
    h16x8 kreg[NKC], vreg[4];
    f32x16 o[4];
#pragma unroll
    for (int j = 0; j < 4; ++j)
#pragma unroll
        for (int i = 0; i < 16; ++i) o[j][i] = 0.f;
    float m_run = -1e30f, l_run = 0.f;
    const int qw0 = q0 + wave * 32, qglob = qw0 + q;
    const int sq = swap23(q);

    const int tk_off = (tid >> 4) * knstride + (tid & 15) * 8;
    const int tr_off = (tid >> 3) * 64 + (tid & 7) * 8;
    const int tv_off = (tid >> 3) * vtstride + (tid & 7) * 8;
    const int lk_off = (tid >> 4) * KSTR + (tid & 15) * 16;
    const int lr_off = (tid >> 3) * KSTR + 256 + (tid & 7) * 16;
    const int lv_off = (tid >> 3) * 144 + (tid & 7) * 16;
#define ATT_LOAD(kt_)                                                                                                 \
    {                                                                                                                 \
        const h16* knp = Kn + (size_t)((kt_) * 64) * knstride;                                                        \
        _Pragma("unroll") for (int i = 0; i < 4; ++i) kreg[i] = *(const h16x8*)(knp + (16 * i) * knstride + tk_off);  \
        if (DK == 192) {                                                                                              \
            const h16* krp = Kr + (size_t)((kt_) * 64) * 64;                                                          \
            _Pragma("unroll") for (int i = 0; i < NKC - 4; ++i) kreg[4 + i] = *(const h16x8*)(krp + (32 * i) * 64 + tr_off); \
        }                                                                                                             \
        const h16* vp = Vt + (size_t)(kt_) * vtile;                                                                   \
        _Pragma("unroll") for (int i = 0; i < 4; ++i) vreg[i] = *(const h16x8*)(vp + (32 * i) * vtstride + tv_off);   \
    }
    ATT_LOAD(0);
    for (int kt = 0; kt < nkt; ++kt) {
        __syncthreads();
#pragma unroll
        for (int i = 0; i < 4; ++i) *(h16x8*)(Ks + lk_off + (16 * i) * KSTR) = kreg[i];
        if (DK == 192) {
#pragma unroll
            for (int i = 0; i < NKC - 4; ++i) *(h16x8*)(Ks + lr_off + (32 * i) * KSTR) = kreg[4 + i];
        }
#pragma unroll
        for (int i = 0; i < 4; ++i) *(h16x8*)(Vs + lv_off + (32 * i) * 144) = vreg[i];
        __syncthreads();
        if (kt + 1 < nkt) ATT_LOAD(kt + 1);
        const bool skip = CAUSAL && (64 * kt > qw0 + 31);
        if (!skip) {
            f32x16 s0, s1;
#pragma unroll
            for (int i = 0; i < 16; ++i) { s0[i] = 0.f; s1[i] = 0.f; }
#pragma unroll
            for (int ks = 0; ks < NKS; ++ks) {
                h16x8 k0 = *(const h16x8*)(Ks + sq * KSTR + (16 * ks + 8 * hf) * 2);
                h16x8 k1 = *(const h16x8*)(Ks + (32 + sq) * KSTR + (16 * ks + 8 * hf) * 2);
                s0 = MFMA32(k0, qf[ks], s0);
                s1 = MFMA32(k1, qf[ks], s1);
            }
            const bool needmask = CAUSAL && (64 * kt + 63 > qw0);
            float mx = -1e30f;
            if (needmask) {
#pragma unroll
                for (int i = 0; i < 16; ++i) {
                    const int key = kt * 64 + 16 * (i >> 3) + 8 * hf + (i & 7);
                    if (key > qglob) s0[i] = -1e30f;
                    if (key + 32 > qglob) s1[i] = -1e30f;
                }
            }
#pragma unroll
            for (int i = 0; i < 16; ++i) mx = fmaxf(mx, fmaxf(s0[i], s1[i]));
            mx = fmaxf(mx, __shfl_xor(mx, 32));
            const float mnew = fmaxf(m_run, mx);
            const float alpha = __builtin_amdgcn_exp2f((m_run - mnew) * sc);
            m_run = mnew;
            const float msc = mnew * sc;
            float rsum = 0.f;
#pragma unroll
            for (int i = 0; i < 16; ++i) {
                float p0 = __builtin_amdgcn_exp2f(fmaf(s0[i], sc, -msc)), p1 = __builtin_amdgcn_exp2f(fmaf(s1[i], sc, -msc));
                s0[i] = p0; s1[i] = p1; rsum += p0 + p1;
            }
            l_run = l_run * alpha + rsum;
            if (__builtin_amdgcn_ballot_w64(alpha != 1.f) != 0ull) {
#pragma unroll
                for (int j = 0; j < 4; ++j)
#pragma unroll
                    for (int i = 0; i < 16; ++i) o[j][i] *= alpha;
            }
#pragma unroll
            for (int t2 = 0; t2 < 4; ++t2) {
                h16x8 pf;
#pragma unroll
                for (int e = 0; e < 8; ++e) pf[e] = (h16)((t2 < 2) ? s0[8 * (t2 & 1) + e] : s1[8 * (t2 & 1) + e]);
#pragma unroll
                for (int j = 0; j < 4; ++j) {
                    h16x8 vf = *(const h16x8*)(Vs + (32 * j + q) * 144 + (16 * t2 + 8 * hf) * 2);
                    o[j] = MFMA32(vf, pf, o[j]);
                }
            }
        }
    }
#undef ATT_LOAD
    const float l = l_run + __shfl_xor(l_run, 32);
    const float inv = 1.f / l;
    __syncthreads();
    {
        char* stg = lds + wave * 8704;
        t_store(o, (h16*)(stg + q * 272), hf, inv);
        t_flush128_mul(stg, outb + (size_t)(wave * 32) * ostride, ostride, lane);
    }
}

DI void mem_attn_phase(const P& p, int layer, int* ctr, char* lds, int tid) {
    const h16* xq = (const h16*)(p.ws + (layer ? OFF_XQ1 : OFF_XQ0));
    const h16* mk = (const h16*)(p.ws + (layer ? OFF_MEMK1 : OFF_MEMK0));
    const h16* mvt = (const h16*)(p.ws + (layer ? OFF_MEMVT1 : OFF_MEMVT0));
    h16* obuf = (h16*)(p.ws + OFF_OBUF);
    volatile int* sitem = (volatile int*)(lds + LDS_ITEM);
    const float sc = 0.08838834764831845f * LOG2E;
    for (;;) {
        __syncthreads();
        if (tid == 0) *sitem = atomicAdd(ctr, 1);
        __syncthreads();
        const int it = *sitem;
        if (it >= 512) break;
        const int b = it >> 6, h = (it >> 4) & 3, qt = it & 15;
        const size_t row0 = (size_t)b * SEQ + qt * 128;
        attn_item<128, false>(xq + row0 * 512 + h * 128, 512, mk + (size_t)((b * 4 + h) * 256) * 128, 128, nullptr,
                              mvt + (size_t)((b * 4 + h) * 128) * 256, 256, 64, 4, 0, obuf + row0 * 2048 + 1536 + h * 128, 2048, sc, lds, tid);
    }
}

template <bool FULL>
DI void s5_seg(const P& p, int g, int bp, int s, char* ldsw, int lane) {
    const h16* u = (const h16*)(p.ws + OFF_U);
    h16* yg = (h16*)(p.ws + OFF_YG);
    const float* At = (const float*)(p.ws + OFF_S5A);
    const h16* Bt = (const h16*)(p.ws + OFF_S5B);
    const h16* Ct = (const h16*)(p.ws + OFF_S5C);
    float4* E = (float4*)(p.ws + OFF_S5E);
    const int q = lane & 31, hf = lane >> 5, c16 = lane & 15, l4 = lane >> 4;
    h16x8 bfr[4];
#pragma unroll
    for (int j = 0; j < 4; ++j) bfr[j] = *(const h16x8*)(Bt + ((size_t)g * 128 + 32 * j + q) * 16 + 8 * hf);
    const float are0 = At[(g * 64 + q) * 2], aim0 = At[(g * 64 + q) * 2 + 1];
    const float are1 = At[(g * 64 + q + 32) * 2], aim1 = At[(g * 64 + q + 32) * 2 + 1];
    float hr0 = 0.f, hi0 = 0.f, hr1 = 0.f, hi1 = 0.f;
    const size_t eidx = (size_t)((g * 4 + bp) * 16) * 64 + hf * 32 + q;
    h16x8 cfr[4];
    float dq = 0.f;
    if (FULL) {
#pragma unroll
        for (int ks = 0; ks < 4; ++ks) cfr[ks] = *(const h16x8*)(Ct + ((size_t)g * 16 + c16) * 128 + 32 * ks + 8 * l4);
        dq = 0.f;
        const float* A128 = (const float*)(p.ws + OFF_S5A128);
        const float pr0 = A128[(g * 64 + q) * 2], pi0 = A128[(g * 64 + q) * 2 + 1];
        const float pr1 = A128[(g * 64 + q + 32) * 2], pi1 = A128[(g * 64 + q + 32) * 2 + 1];
        for (int j = 0; j < s; ++j) {
            const float4 e = E[eidx + (size_t)j * 64];
            const float nr0 = fmaf(pr0, hr0, fmaf(-pi0, hi0, e.x)), ni0 = fmaf(pr0, hi0, fmaf(pi0, hr0, e.z));
            const float nr1 = fmaf(pr1, hr1, fmaf(-pi1, hi1, e.y)), ni1 = fmaf(pr1, hi1, fmaf(pi1, hr1, e.w));
            hr0 = nr0; hi0 = ni0; hr1 = nr1; hi1 = ni1;
        }
    }
    const int aseq = (q >> 2) & 1, att = (q & 3) + 4 * (q >> 3);
    const h16* ua = u + (size_t)g * TOK * 16 + ((size_t)(2 * bp + aseq) * SEQ + s * 128 + att) * 16 + 8 * hf;
    const float4 d4 = FULL ? *(const float4*)(p.s5_d + g * 16 + 4 * l4) : make_float4(0.f, 0.f, 0.f, 0.f);
    char* us = ldsw + 8704;
    h16x8 afn = *(const h16x8*)ua;
    for (int ch = 0; ch < 8; ++ch) {
        const h16x8 af = afn;
        if (ch + 1 < 8) afn = *(const h16x8*)(ua + (size_t)(ch + 1) * 16 * 16);
        f32x16 z;
#pragma unroll
        for (int i = 0; i < 16; ++i) z[i] = 0.f;
        f32x16 a0 = MFMA32(af, bfr[0], z), a1 = MFMA32(af, bfr[1], z), a2 = MFMA32(af, bfr[2], z), a3 = MFMA32(af, bfr[3], z);
        if (FULL) *(h16x8*)(us + (aseq * 16 + att) * 32 + hf * 16) = af;
#pragma unroll
        for (int i = 0; i < 16; ++i) {
            const float nr0 = fmaf(are0, hr0, fmaf(-aim0, hi0, a0[i]));
            const float ni0 = fmaf(are0, hi0, fmaf(aim0, hr0, a2[i]));
            const float nr1 = fmaf(are1, hr1, fmaf(-aim1, hi1, a1[i]));
            const float ni1 = fmaf(are1, hi1, fmaf(aim1, hr1, a3[i]));
            hr0 = nr0; hi0 = ni0; hr1 = nr1; hi1 = ni1;
            if (FULL) {
                h16x4 hv; hv[0] = (h16)hr0; hv[1] = (h16)hr1; hv[2] = (h16)hi0; hv[3] = (h16)hi1;
                *(h16x4*)(ldsw + (hf * 16 + i) * 272 + q * 8) = hv;
            }
        }
        if (FULL) {
            asm volatile("s_waitcnt lgkmcnt(0)" ::: "memory");
            __builtin_amdgcn_wave_barrier();
#pragma unroll
            for (int sq = 0; sq < 2; ++sq) {
                f32x4 y; y[0] = 0.f; y[1] = 0.f; y[2] = 0.f; y[3] = 0.f;
#pragma unroll
                for (int ks = 0; ks < 4; ++ks) {
                    const h16x8 hfr = *(const h16x8*)(ldsw + (sq * 16 + c16) * 272 + (32 * ks + 8 * l4) * 2);
                    y = MFMA16(cfr[ks], hfr, y);
                }
                const h16x4 uu = *(const h16x4*)(us + (sq * 16 + c16) * 32 + l4 * 8);
                h16x4 ov;
                ov[0] = (h16)geluf_(y[0] * (1.f / 1024.f) + d4.x * (float)uu[0]);
                ov[1] = (h16)geluf_(y[1] * (1.f / 1024.f) + d4.y * (float)uu[1]);
                ov[2] = (h16)geluf_(y[2] * (1.f / 1024.f) + d4.z * (float)uu[2]);
                ov[3] = (h16)geluf_(y[3] * (1.f / 1024.f) + d4.w * (float)uu[3]);
                *(h16x4*)(yg + (size_t)g * TOK * 16 + ((size_t)(2 * bp + sq) * SEQ + s * 128 + ch * 16 + c16) * 16 + 4 * l4) = ov;
            }
            asm volatile("s_waitcnt lgkmcnt(0)" ::: "memory");
            __builtin_amdgcn_wave_barrier();
        }
    }
    if (!FULL) E[eidx + (size_t)s * 64] = make_float4(hr0, hr1, hi0, hi1);
}

DI void s5_segA2(const P& p, int ita, int itb, int lane) {
    const h16* u = (const h16*)(p.ws + OFF_U);
    const float* At = (const float*)(p.ws + OFF_S5A);
    const h16* Bt = (const h16*)(p.ws + OFF_S5B);
    float4* E = (float4*)(p.ws + OFF_S5E);
    const int q = lane & 31, hf = lane >> 5;
    const int aseq = (q >> 2) & 1, att = (q & 3) + 4 * (q >> 3);
    h16x8 bfr[2][4];
    float are0[2], aim0[2], are1[2], aim1[2], hr0[2], hi0[2], hr1[2], hi1[2];
    const h16* ua[2];
    size_t eo[2];
#pragma unroll
    for (int k = 0; k < 2; ++k) {
        const int it = k ? itb : ita, g = it >> 6, bp = (it >> 4) & 3, sg = it & 15;
#pragma unroll
        for (int j = 0; j < 4; ++j) bfr[k][j] = *(const h16x8*)(Bt + ((size_t)g * 128 + 32 * j + q) * 16 + 8 * hf);
        are0[k] = At[(g * 64 + q) * 2]; aim0[k] = At[(g * 64 + q) * 2 + 1];
        are1[k] = At[(g * 64 + q + 32) * 2]; aim1[k] = At[(g * 64 + q + 32) * 2 + 1];
        hr0[k] = 0.f; hi0[k] = 0.f; hr1[k] = 0.f; hi1[k] = 0.f;
        ua[k] = u + (size_t)g * TOK * 16 + ((size_t)(2 * bp + aseq) * SEQ + sg * 128 + att) * 16 + 8 * hf;
        eo[k] = (size_t)((g * 4 + bp) * 16 + sg) * 64 + hf * 32 + q;
    }
    h16x8 afn[2];
#pragma unroll
    for (int k = 0; k < 2; ++k) afn[k] = *(const h16x8*)ua[k];
    for (int ch = 0; ch < 8; ++ch) {
        f32x16 z;
#pragma unroll
        for (int i = 0; i < 16; ++i) z[i] = 0.f;
        f32x16 a0[2], a1[2], a2[2], a3[2];
#pragma unroll
        for (int k = 0; k < 2; ++k) {
            const h16x8 af = afn[k];
            if (ch + 1 < 8) afn[k] = *(const h16x8*)(ua[k] + (size_t)(ch + 1) * 16 * 16);
            a0[k] = MFMA32(af, bfr[k][0], z); a1[k] = MFMA32(af, bfr[k][1], z);
            a2[k] = MFMA32(af, bfr[k][2], z); a3[k] = MFMA32(af, bfr[k][3], z);
        }
#pragma unroll
        for (int i = 0; i < 16; ++i)
#pragma unroll
            for (int k = 0; k < 2; ++k) {
                const float nr0 = fmaf(are0[k], hr0[k], fmaf(-aim0[k], hi0[k], a0[k][i]));
                const float ni0 = fmaf(are0[k], hi0[k], fmaf(aim0[k], hr0[k], a2[k][i]));
                const float nr1 = fmaf(are1[k], hr1[k], fmaf(-aim1[k], hi1[k], a1[k][i]));
                const float ni1 = fmaf(are1[k], hi1[k], fmaf(aim1[k], hr1[k], a3[k][i]));
                hr0[k] = nr0; hi0[k] = ni0; hr1[k] = nr1; hi1[k] = ni1;
            }
    }
#pragma unroll
    for (int k = 0; k < 2; ++k) E[eo[k]] = make_float4(hr0[k], hr1[k], hi0[k], hi1[k]);
}

#define XB_TMO      128
#define XB_XCNT(j)  (256  + 64 * (j))
#define XB_XSUB(j)  (1280 + 64 * (j))
#define XB_XGEN(j)  (2304 + 64 * (j))
#define XB_TOP      3328
#define XB_TOPGEN   3392
#define XCD_BAR_WORDS 3456
#define XB_SPIN_CAP (1u << 22)
#define LAS __attribute__((address_space(3)))
DI unsigned xb_ld(unsigned* p) { return __hip_atomic_load(p, __ATOMIC_RELAXED, __HIP_MEMORY_SCOPE_AGENT); }
DI unsigned xb_add(unsigned* p, unsigned v) { return __hip_atomic_fetch_add(p, v, __ATOMIC_RELAXED, __HIP_MEMORY_SCOPE_AGENT); }
DI unsigned xb_xcc_id() { return (unsigned)__builtin_amdgcn_s_getreg((3 << 11) | 20) & 0xFu; }
#define XB_SPIN(cond, bar) do { unsigned _sp = 0; while (cond) { __builtin_amdgcn_s_sleep(1); \
    if ((++_sp & 255u) == 0u) { if (xb_ld(&(bar)[XB_TMO])) break; if (_sp > XB_SPIN_CAP) { atomicAdd(&(bar)[XB_TMO], 1u); break; } } } } while (0)
struct XcdBarrier { unsigned* bar; unsigned x; volatile LAS unsigned* st; };
DI XcdBarrier xcd_barrier_post(unsigned* bar, volatile LAS unsigned* st) {
    XcdBarrier b; b.bar = bar; b.x = xb_xcc_id(); b.st = st;
    if (threadIdx.x == 0) (void)xb_add(&bar[XB_XCNT(b.x)], 1u);
    return b;
}
DI void xcd_barrier_complete(unsigned* bar, unsigned x, unsigned& nloc, unsigned& nx) {
    const unsigned G = gridDim.x * gridDim.y * gridDim.z;
    unsigned sum, cnt, mine, sp = 0u;
    for (;;) {
        sum = 0u; cnt = 0u; mine = 0u;
#pragma unroll
        for (unsigned j = 0; j < 16; ++j) { const unsigned c = xb_ld(&bar[XB_XCNT(j)]); sum += c; cnt += (c > 0u) ? 1u : 0u; mine = (j == x) ? c : mine; }
        if (sum == G) break;
        __builtin_amdgcn_s_sleep(1);
        if ((++sp & 255u) == 0u) { if (xb_ld(&bar[XB_TMO])) break; if (sp > XB_SPIN_CAP) { atomicAdd(&bar[XB_TMO], 1u); break; } }
    }
    nloc = mine > 0u ? mine : 1u; nx = cnt > 0u ? cnt : 1u;
}
DI void xcd_barrier(const XcdBarrier& b) {
    asm volatile("s_waitcnt vmcnt(0)" ::: "memory");
    __syncthreads();
    if (threadIdx.x == 0) {
        unsigned* bar = b.bar;
        __builtin_amdgcn_s_waitcnt(0);
        unsigned nloc = b.st[0], nx = b.st[1];
        if (nloc == 0u) { xcd_barrier_complete(bar, b.x, nloc, nx); b.st[0] = nloc; b.st[1] = nx; }
        const unsigned old = xb_add(&bar[XB_XSUB(b.x)], 1u);
        const unsigned gen = old / nloc;
        if (old + 1u == (gen + 1u) * nloc) {
            __builtin_amdgcn_fence(__ATOMIC_RELEASE, "agent");
            asm volatile("s_waitcnt vmcnt(0)" ::: "memory");
            const unsigned og = xb_add(&bar[XB_TOP], 1u);
            const unsigned tg = og / nx;
            if (og + 1u == (tg + 1u) * nx) xb_add(&bar[XB_TOPGEN], 1u);
            else XB_SPIN(xb_ld(&bar[XB_TOPGEN]) == tg, bar);
            __builtin_amdgcn_fence(__ATOMIC_ACQUIRE, "agent");
            xb_add(&bar[XB_XGEN(b.x)], 1u);
            asm volatile("s_waitcnt vmcnt(0)" ::: "memory");
        } else {
            XB_SPIN(xb_ld(&bar[XB_XGEN(b.x)]) == gen, bar);
            __builtin_amdgcn_fence(__ATOMIC_ACQUIRE, "agent");
            asm volatile("s_waitcnt vmcnt(0)" ::: "memory");
        }
    }
    __syncthreads();
}

DI bool tile_map(int bid, int nblk, int it, int NT, int& mt, int& nt) {
    const int x = bid & 7, li = bid >> 3, nper = nblk >> 3;
    const int n = li + it * nper;
    if (n >= 16 * NT) return false;
    mt = x * 16 + (n / (8 * NT)) * 8 + (n & 7);
    nt = (n >> 3) % NT;
    return true;
}

__global__ void __launch_bounds__(256, 2) mega(P p, int lo, int hi) {
    __shared__ __attribute__((aligned(16))) char lds[LDS_BYTES];
    cg::grid_group grid = cg::this_grid();
#define IDS const int tid = threadIdx.x, lane = tid & 63, wave = __builtin_amdgcn_readfirstlane(tid >> 6), q = lane & 31, hf = lane >> 5; const int bid = blockIdx.x, nblk = gridDim.x; (void)lane; (void)wave; (void)q; (void)hf; (void)bid; (void)nblk;
    int* ctr = (int*)(p.ws + OFF_CTR);
    h16* obuf = (h16*)(p.ws + OFF_OBUF);
    const float* rs = (const float*)(lds + LDS_RS);

#ifndef ONLY
#define ONLY -1
#endif
#define RUN(k) ((ONLY < 0 || ONLY == (k)) && lo <= (k) && (k) < hi)
#define SYNC(k) if (RUN(k) && RUN((k) + 1)) xcd_barrier(xb);
    if (threadIdx.x < 4) ((volatile LAS unsigned*)(lds + LDS_XB))[threadIdx.x] = 0u;
    __syncthreads();
    XcdBarrier xb = xcd_barrier_post((unsigned*)(p.ws + OFF_BAR), (volatile LAS unsigned*)(lds + LDS_XB));
    if (hi > 1000) grid.sync();
    if (RUN(0)) {
            IDS
            for (int rep = 0; rep < NREP(0); ++rep)
            { int rot = 0; for (int m = 0; m < 7; ++m) rot += conv_matrix(p, m, bid, nblk, (float*)lds, tid, rot); }
            rmsnorm_rows(p.x, p.ln_gain, (h16*)(p.ws + OFF_XN0), TOK, bid * 4 + wave, nblk * 4, lane);
            rmsnorm_rows(p.mem, p.mem_norm, (h16*)(p.ws + OFF_MEMN0), 2048, bid * 4 + wave, nblk * 4, lane);
            rmsnorm_rows(p.mem, p.mem_norm + DM, (h16*)(p.ws + OFF_MEMN1), 2048, bid * 4 + wave, nblk * 4, lane);
            s5_tables(p, bid * 256 + tid, nblk * 256);
            for (int i = bid * 256 + tid; i < 3 * TOK; i += nblk * 256) ((float*)(p.ws + OFF_ROWSS))[i] = 0.f;
    }
    SYNC(0)
    if (RUN(1)) {
            IDS
            const h16* xn = (const h16*)(p.ws + OFF_XN0);
            const h16* w = (const h16*)(p.ws + OFF_WIN0);
            for (int rep = 0; rep < NREP(1); ++rep)
            for (int it = 0;; ++it) {
                int mt, nt;
                if (!tile_map256(bid, nblk, it, 32, mt, nt)) break;
                const int m0 = mt * 256, n0 = nt * 128;
                f32x16 acc2[2][4];
                gemm_tile256<true>(xn + (size_t)m0 * DM, DM, w + (size_t)n0 * DM, DM, DM, lds, acc2, tid);
                __syncthreads();
                char* stg = lds + wave * 8704;
                const size_t rw = (size_t)(m0 + wave * 64);
                const int mode = (n0 < 1536) ? 0 : (n0 < 2048 ? 1 : 2);
                h16* dst = (n0 < 1536) ? (h16*)(p.ws + OFF_U) + (size_t)(n0 >> 4) * TOK * 16 + rw * 16
                         : (n0 < 2048) ? (h16*)(p.ws + OFF_XQ0) + rw * 512 + (n0 - 1536) : obuf + rw * 2048 + (n0 - 2048);
                const int ld = (n0 < 1536) ? 0 : (n0 < 2048 ? 512 : 2048);
                const int hstep = (n0 < 1536) ? 32 * 16 : 32 * ld;
#pragma unroll
                for (int hh = 0; hh < 2; ++hh) t_epi(acc2[hh], mode, p.xq_norm, 1.f, stg, dst + (size_t)hh * hstep, ld, q, hf, lane);
            }
            for (int t2 = bid; t2 < 256; t2 += nblk) {
                f32x16 acc[4];
                const int layer = t2 >> 7, mt = (t2 >> 3) & 15, nt = t2 & 7;
                const h16* mn = (const h16*)(p.ws + (layer ? OFF_MEMN1 : OFF_MEMN0));
                const h16* wm = (const h16*)(p.ws + (layer ? OFF_WMKV1 : OFF_WMKV0));
                const int m0 = mt * 128, b = m0 >> 8, key0 = m0 & 255;
                if (nt < 4) {
                    gemm_tile<true>(mn + (size_t)m0 * DM, DM, wm + (size_t)(nt * 128) * DM, DM, DM, lds, acc, tid);
                    h16* mk = (h16*)(p.ws + (layer ? OFF_MEMK1 : OFF_MEMK0));
                    __syncthreads();
                    char* stg = lds + wave * 8704;
                    t_norm128(acc, 1.f, (h16*)(stg + q * 272), hf);
                    t_flush128g(stg, mk + (size_t)((b * 4 + nt) * 256 + key0 + wave * 32) * 128, 128, p.xk_norm + layer * 128, lane);
                } else {
                    const int h = nt - 4;
                    gemm_tile<false>(mn + (size_t)m0 * DM, DM, wm + (size_t)(512 + h * 128) * DM, DM, DM, lds, acc, tid);
                    h16* mvt = (h16*)(p.ws + (layer ? OFF_MEMVT1 : OFF_MEMVT0)) + (size_t)((b * 4 + h) * 128) * 256 + key0 + wave * 32 + 4 * hf;
#pragma unroll
                    for (int j = 0; j < 4; ++j)
#pragma unroll
                        for (int g4 = 0; g4 < 4; ++g4) {
                            h16x4 v;
#pragma unroll
                            for (int e = 0; e < 4; ++e) v[e] = (h16)acc[j][4 * g4 + e];
                            *(h16x4*)(mvt + (size_t)(32 * j + q) * 256 + 8 * g4) = v;
                        }
                }
            }
    }
    SYNC(1)
    if (RUN(2)) {
            IDS
            for (int it = bid * 4 + wave; it < 6144; it += 8 * nblk) {
                const int itb = it + 4 * nblk;
                const bool va = (it & 15) != 15, vb = itb < 6144 && (itb & 15) != 15;
                if (va && vb) s5_segA2(p, it, itb, lane);
                else {
                    if (va) s5_seg<false>(p, it >> 6, (it >> 4) & 3, it & 15, lds + wave * 9728, lane);
                    if (vb) s5_seg<false>(p, itb >> 6, (itb >> 4) & 3, itb & 15, lds + wave * 9728, lane);
                }
            }
            mem_attn_phase(p, 0, ctr + 0, lds, tid);
    }
    SYNC(2)
    if (RUN(3)) {
            IDS
            for (int it = bid * 4 + wave; it < 6144; it += 4 * nblk)
                s5_seg<true>(p, it >> 6, (it >> 4) & 3, it & 15, lds + wave * 9728, lane);
    }
    SYNC(3)
    if (RUN(4)) {
            IDS
            const h16* ygp = (const h16*)(p.ws + OFF_YG);
            const h16* w = (const h16*)(p.ws + OFF_WGLU);
            for (int it = 0;; ++it) {
                int mt, nt;
                if (!tile_map256(bid, nblk, it, 24, mt, nt)) break;
                const int m0 = mt * 256;
                f32x16 acc2[2][4];
                gemm_tile256<true, true>(ygp + (size_t)m0 * 16, 0, w + (size_t)(nt * 128) * 1536, 1536, 1536, lds, acc2, tid);
                __syncthreads();
                char* stg = lds + wave * 8704;
#pragma unroll
                for (int hh = 0; hh < 2; ++hh) {
                    h16* srow = (h16*)(stg + q * 272) + 4 * hf;
#pragma unroll
                    for (int j = 0; j < 2; ++j)
#pragma unroll
                        for (int g4 = 0; g4 < 4; ++g4) {
                            h16x4 v;
#pragma unroll
                            for (int e = 0; e < 4; ++e) v[e] = (h16)(acc2[hh][j][4 * g4 + e] * sigmoidf_(acc2[hh][j + 2][4 * g4 + e]));
                            *(h16x4*)(srow + 32 * j + 8 * g4) = v;
                        }
                    t_flush64_mul(stg, obuf + (size_t)(m0 + wave * 64 + hh * 32) * 2048 + nt * 64, 2048, lane);
                }
            }
    }
    SYNC(4)
    if (RUN(5)) {
            IDS
            const h16* w = (const h16*)(p.ws + OFF_WOUT0);
            const float* xin = p.x;
            float* rowss = (float*)(p.ws + OFF_ROWSS);
            h16* xr = (h16*)(p.ws + OFF_XN1);
            for (int it = 0;; ++it) {
                int mt, nt;
                if (!tile_map256(bid, nblk, it, 8, mt, nt)) break;
                const int m0 = mt * 256, n0 = nt * 128;
                f32x16 acc2[2][4];
                gemm_tile256<false>(obuf + (size_t)m0 * 2048, 2048, w + (size_t)n0 * 2048, 2048, 2048, lds, acc2, tid);
                __syncthreads();
                char* stg = lds + wave * 8704;
#pragma unroll
                for (int hh = 0; hh < 2; ++hh) {
                    const int r0 = m0 + wave * 64 + hh * 32;
                    const size_t ob = (size_t)(r0 + 4 * hf) * DM + n0 + q;
                    float xv[16][4];
#pragma unroll
                    for (int i = 0; i < 16; ++i)
#pragma unroll
                        for (int j = 0; j < 4; ++j) xv[i][j] = __builtin_nontemporal_load(xin + ob + (size_t)((i & 3) + 8 * (i >> 2)) * DM + 32 * j);
#pragma unroll
                    for (int i = 0; i < 16; ++i) {
                        const int r = (i & 3) + 8 * (i >> 2);
                        float ss = 0.f;
#pragma unroll
                        for (int j = 0; j < 4; ++j) {
                            const float v = xv[i][j] + acc2[hh][j][i];
                            p.out[ob + (size_t)r * DM + 32 * j] = v;
                            *(h16*)(stg + (r + 4 * hf) * 272 + (32 * j + q) * 2) = (h16)v;
                            ss += v * v;
                        }
                        ss = half_sum(ss);
                        if (q == 0) atomicAdd(&rowss[r0 + r + 4 * hf], ss);
                    }
                    t_flush128(stg, xr + (size_t)r0 * DM + n0, DM, lane);
                }
            }
            { const int r7 = conv_matrix(p, 7, bid, nblk, (float*)lds, tid, 0); conv_matrix(p, 8, bid, nblk, (float*)lds, tid, r7); }
    }
    SYNC(5)
    if (RUN(7)) {
            IDS
            const h16* xn = (const h16*)(p.ws + OFF_XN1);
            const h16* w = (const h16*)(p.ws + OFF_WIN1);
            const float* rowss = (const float*)(p.ws + OFF_ROWSS);
            const int nper7 = nblk >> 3, full7 = (8 * 26) / nper7;
            for (int it = 0; it < full7; ++it) {
                int mt, nt;
                if (!tile_map256(bid, nblk, it, 26, mt, nt)) break;
                const int m0 = mt * 256, n0 = nt * 128;
                f32x16 acc2[2][4];
                gemm_tile256<true>(xn + (size_t)m0 * DM, DM, w + (size_t)n0 * DM, DM, DM, lds, acc2, tid);
                __syncthreads();
                char* stg = lds + wave * 8704;
                const size_t rw = (size_t)(m0 + wave * 64);
                {
                    const int mode = (nt < 6) ? 0 : (nt < 10 ? 1 : 2);
                    h16* dst = (nt < 4) ? (h16*)(p.ws + OFF_CQ) + rw * 512 + n0
                             : (nt < 6) ? (h16*)(p.ws + OFF_CKV) + rw * 256 + (n0 - 512)
                             : (nt < 10) ? (h16*)(p.ws + OFF_XQ1) + rw * 512 + (n0 - 768) : obuf + rw * 2048 + (n0 - 1280);
                    const int ld = (nt < 4) ? 512 : (nt < 6 ? 256 : (nt < 10 ? 512 : 2048));
#pragma unroll
                    for (int hh = 0; hh < 2; ++hh) {
                        const float pre = rsqrtf(rowss[rw + hh * 32 + q] * (1.f / DM) + EPS);
                        if (nt < 6) t_rowss(acc2[hh], pre, (float*)(p.ws + (nt < 4 ? OFF_ROWSS2 : OFF_ROWSS3)) + rw + hh * 32 + q, hf);
                        t_epi(acc2[hh], mode, p.xq_norm + 128, pre, stg, dst + (size_t)(hh * 32) * ld, ld, q, hf, lane);
                    }
                }
            }
            for (int st = (bid >> 3); st < 2 * (8 * 26 - full7 * nper7); st += nper7) {
                const int n = full7 * nper7 + (st >> 1), half = st & 1;
                const int mt = (bid & 7) * 8 + (n / (4 * 26)) * 4 + (n & 3), nt = (n >> 2) % 26;
                const int m0 = mt * 256 + half * 128, n0 = nt * 128;
                f32x16 acc[4];
                gemm_tile<true>(xn + (size_t)m0 * DM, DM, w + (size_t)n0 * DM, DM, DM, lds, acc, tid);
                __syncthreads();
                char* stg = lds + wave * 8704;
                const size_t rw = (size_t)(m0 + wave * 32);
                const int mode = (nt < 6) ? 0 : (nt < 10 ? 1 : 2);
                h16* dst = (nt < 4) ? (h16*)(p.ws + OFF_CQ) + rw * 512 + n0
                         : (nt < 6) ? (h16*)(p.ws + OFF_CKV) + rw * 256 + (n0 - 512)
                         : (nt < 10) ? (h16*)(p.ws + OFF_XQ1) + rw * 512 + (n0 - 768) : obuf + rw * 2048 + (n0 - 1280);
                const int ld = (nt < 4) ? 512 : (nt < 6 ? 256 : (nt < 10 ? 512 : 2048));
                const float pre = rsqrtf(rowss[rw + q] * (1.f / DM) + EPS);
                if (nt < 6) t_rowss(acc, pre, (float*)(p.ws + (nt < 4 ? OFF_ROWSS2 : OFF_ROWSS3)) + rw + q, hf);
                t_epi(acc, mode, p.xq_norm + 128, pre, stg, dst, ld, q, hf, lane);
            }
            for (int t2 = nblk - 1 - bid; t2 < 128; t2 += nblk) {
                f32x16 acc[4];
                const int m0 = t2 * 128;
                gemm_tile<true>(xn + (size_t)m0 * DM, DM, w + (size_t)(26 * 128) * DM, DM, DM, lds, acc, tid);
                const size_t row = (size_t)(m0 + wave * 32 + q);
                __syncthreads();
                char* stg = lds + wave * 8704;
                t_rope64(acc[0], acc[1], p.k_rope_norm, rsqrtf(rowss[row] * (1.f / DM) + EPS), (float)p.pos[row], (h16*)(stg + q * 272), hf);
                t_flush64(stg, (h16*)(p.ws + OFF_KR) + (size_t)(m0 + wave * 32) * 64, 64, lane);
            }
    }
    SYNC(7)
    if (RUN(8)) {
            IDS
            const h16* cq = (const h16*)(p.ws + OFF_CQ);
            const h16* w = (const h16*)(p.ws + OFF_WUQ);
            h16* Q = (h16*)(p.ws + OFF_Q);
            for (int it = 0;; ++it) {
                int mt, nt;
                if (!tile_map(bid, nblk, it, 18, mt, nt)) break;
                const int m0 = mt * 128;
                f32x16 acc[4];
                gemm_tile<true>(cq + (size_t)m0 * 512, 512, w + (size_t)(nt * 128) * 512, 512, 512, lds, acc, tid);
                const int b = m0 >> 11, l = (m0 & 2047) + wave * 32 + q;
                const float pre = rsqrtf(((const float*)(p.ws + OFF_ROWSS2))[m0 + wave * 32 + q] * (1.f / 512.f) + EPS);
                if (nt < 12) {
                    __syncthreads();
                    char* stg = lds + wave * 8704;
                    t_norm128(acc, pre, (h16*)(stg + q * 272), hf);
                    t_flush128g(stg, Q + ((size_t)(b * 12 + nt) * SEQ + (l - q)) * 192, 192, p.q_nope_norm, lane);
                } else {
                    const int hA = 2 * (nt - 12);
                    const float posf = (float)p.pos[m0 + wave * 32 + q];
                    __syncthreads();
                    char* stg = lds + wave * 8704;
                    t_rope64(acc[0], acc[1], p.q_rope_norm, pre, posf, (h16*)(stg + q * 272), hf);
                    t_flush64(stg, Q + ((size_t)(b * 12 + hA) * SEQ + (l - q)) * 192 + 128, 192, lane);
                    t_rope64(acc[2], acc[3], p.q_rope_norm, pre, posf, (h16*)(stg + q * 272), hf);
                    t_flush64(stg, Q + ((size_t)(b * 12 + hA + 1) * SEQ + (l - q)) * 192 + 128, 192, lane);
                }
            }
            mem_attn_phase(p, 1, ctr + 1, lds, tid);
    }
    SYNC(8)
    if (RUN(9)) {
            IDS
            const h16* ckv = (const h16*)(p.ws + OFF_CKV);
            const h16* w = (const h16*)(p.ws + OFF_WUKV);
            for (int it = 0;; ++it) {
                int mt, nt;
                if (!tile_map(bid, nblk, it, 24, mt, nt)) break;
                const int m0 = mt * 128, h = nt >> 1;
                f32x16 acc[4];
                const float* rss3 = (const float*)(p.ws + OFF_ROWSS3) + m0 + wave * 32;
                const int b = m0 >> 11, l0 = (m0 & 2047) + wave * 32;
                if ((nt & 1) == 0) {
                    gemm_tile<true>(ckv + (size_t)m0 * 256, 256, w + (size_t)(h * 256) * 256, 256, 256, lds, acc, tid);
                    h16* Kn = (h16*)(p.ws + OFF_KN);
                    __syncthreads();
                    char* stg = lds + wave * 8704;
                    t_norm128(acc, rsqrtf(rss3[q] * (1.f / 256.f) + EPS), (h16*)(stg + q * 272), hf);
                    t_flush128g(stg, Kn + ((size_t)(b * 12 + h) * SEQ + l0) * 128, 128, p.k_nope_norm, lane);
                } else {
                    gemm_tile<false>(ckv + (size_t)m0 * 256, 256, w + (size_t)(h * 256 + 128) * 256, 256, 256, lds, acc, tid);
                    __syncthreads();
                    {
                        char* img = lds + ((wave >> 1) * 128 + q) * 136 + ((wave & 1) * 32 + 4 * hf) * 2;
#pragma unroll
                        for (int g4 = 0; g4 < 4; ++g4) {
                            const float4 s4 = *(const float4*)(rss3 + 8 * g4 + 4 * hf);
                            float4 pr;
                            pr.x = rsqrtf(s4.x * (1.f / 256.f) + EPS); pr.y = rsqrtf(s4.y * (1.f / 256.f) + EPS);
                            pr.z = rsqrtf(s4.z * (1.f / 256.f) + EPS); pr.w = rsqrtf(s4.w * (1.f / 256.f) + EPS);
#pragma unroll
                            for (int j = 0; j < 4; ++j) {
                                h16x4 v;
                                v[0] = (h16)(acc[j][4 * g4 + 0] * pr.x); v[1] = (h16)(acc[j][4 * g4 + 1] * pr.y);
                                v[2] = (h16)(acc[j][4 * g4 + 2] * pr.z); v[3] = (h16)(acc[j][4 * g4 + 3] * pr.w);
                                *(h16x4*)(img + (32 * j) * 136 + 8 * g4 * 2) = v;
                            }
                        }
                    }
                    __syncthreads();
                    {
                        h16* Vt = (h16*)(p.ws + OFF_VT) + (size_t)(b * 12 + h) * 128 * SEQ + (size_t)((m0 & 2047) >> 6) * 8192;
#pragma unroll
                        for (int i = 0; i < 8; ++i) {
                            const int cidx = tid + 256 * i, row = cidx >> 3, c = cidx & 7;
                            *(h16x8*)(Vt + (size_t)row * 64 + c * 8) = *(const h16x8*)(lds + row * 136 + c * 16);
                        }
                    }
                }
            }
    }
    SYNC(9)
    if (RUN(10)) {
            IDS
            const h16* Q = (const h16*)(p.ws + OFF_Q);
            const h16* Kn = (const h16*)(p.ws + OFF_KN);
            const h16* Kr = (const h16*)(p.ws + OFF_KR);
            const h16* Vt = (const h16*)(p.ws + OFF_VT);
            volatile int* sitem = (volatile int*)(lds + LDS_ITEM);
            const float sc = 0.07216878364870322f * LOG2E;
            for (int rep = 0; rep < NREP(9); ++rep)
            for (;;) {
                __syncthreads();
                if (tid == 0) *sitem = atomicAdd(ctr + 2 + (NREP(9) - 1 - rep) * 4, 1);
                __syncthreads();
                const int it = *sitem;
                if (it >= 1536) break;
                const int qt = 15 - it / 96, bh = it % 96, b = bh / 12, h = bh % 12;
                const bool dummy = (rep + 1 < NREP(9));
                attn_item<192, true>(Q + ((size_t)bh * SEQ + qt * 128) * 192, 192, Kn + (size_t)bh * SEQ * 128, 128, Kr + (size_t)b * SEQ * 64,
                                     Vt + (size_t)bh * 128 * SEQ, 64, 8192, 2 * qt + 2, qt * 128,
                                     dummy ? (h16*)(p.ws + OFF_CKV) : obuf + ((size_t)b * SEQ + qt * 128) * 2048 + h * 128, dummy ? 0 : 2048, sc, lds, tid);
            }
    }
    SYNC(10)
    if (RUN(11)) {
            IDS
            const h16* w = (const h16*)(p.ws + OFF_WOUT1);
            const float* xin = p.out;
            for (int it = 0;; ++it) {
                int mt, nt;
                if (!tile_map256(bid, nblk, it, 8, mt, nt)) break;
                const int m0 = mt * 256, n0 = nt * 128;
                f32x16 acc2[2][4];
                gemm_tile256<false>(obuf + (size_t)m0 * 2048, 2048, w + (size_t)n0 * 2048, 2048, 2048, lds, acc2, tid);
#pragma unroll
                for (int hh = 0; hh < 2; ++hh) {
                    const size_t ob = (size_t)(m0 + wave * 64 + hh * 32 + 4 * hf) * DM + n0 + q;
                    float xv[16][4];
#pragma unroll
                    for (int i = 0; i < 16; ++i)
#pragma unroll
                        for (int j = 0; j < 4; ++j) xv[i][j] = __builtin_nontemporal_load(xin + ob + (size_t)((i & 3) + 8 * (i >> 2)) * DM + 32 * j);
#pragma unroll
                    for (int i = 0; i < 16; ++i)
#pragma unroll
                        for (int j = 0; j < 4; ++j) __builtin_nontemporal_store(xv[i][j] + acc2[hh][j][i], p.out + ob + (size_t)((i & 3) + 8 * (i >> 2)) * DM + 32 * j);
                }
            }
    }
}

extern "C" void kernel_launch(void* const* d_in, const int* in_sizes, int n_in, void* d_out, int out_size, void* d_ws, size_t ws_size,
                              hipStream_t stream) {
    static int grid = 0;
    if (!grid) {
        int dev = 0, cus = 0, per_cu = 0;
        hipGetDevice(&dev);
        hipDeviceGetAttribute(&cus, hipDeviceAttributeMultiprocessorCount, dev);
        hipOccupancyMaxActiveBlocksPerMultiprocessor(&per_cu, mega, 256, 0);
        if (per_cu < 1) per_cu = 1;
        if (per_cu > 2) per_cu = 2;
        grid = cus * per_cu;
    }
    P p{};
    p.x = (const float*)d_in[0]; p.mem = (const float*)d_in[1]; p.pos = (const int*)d_in[2];
    p.ln_gain = (const float*)d_in[3]; p.w_out = (const float*)d_in[4]; p.mem_norm = (const float*)d_in[5];
    p.w_mem_kv = (const float*)d_in[6]; p.xq_norm = (const float*)d_in[7]; p.xk_norm = (const float*)d_in[8];
    p.s5_w_in = (const float*)d_in[9]; p.lam_re = (const float*)d_in[10]; p.lam_im = (const float*)d_in[11];
    p.log_step = (const float*)d_in[12]; p.b_re = (const float*)d_in[13]; p.b_im = (const float*)d_in[14];
    p.c_re = (const float*)d_in[15]; p.c_im = (const float*)d_in[16]; p.s5_d = (const float*)d_in[17]; p.w_glu = (const float*)d_in[18];
    p.mla_w_in = (const float*)d_in[19]; p.q_lora_norm = (const float*)d_in[20]; p.kv_lora_norm = (const float*)d_in[21];
    p.w_uq = (const float*)d_in[22]; p.w_ukv = (const float*)d_in[23]; p.q_nope_norm = (const float*)d_in[24];
    p.k_nope_norm = (const float*)d_in[25]; p.q_rope_norm = (const float*)d_in[26]; p.k_rope_norm = (const float*)d_in[27];
    p.out = (float*)d_out; p.ws = (char*)d_ws;
    hipMemsetAsync(d_ws, 0, 32768, stream);
#if MULTI_LAUNCH
    for (int ph = 0; ph < 12; ++ph) hipLaunchKernelGGL(mega, dim3(grid), dim3(256), 0, stream, p, ph, ph + 1);
#else
    int lo = 0, hi = 12;
    void* args[] = {&p, &lo, &hi};
    hipError_t e = hipLaunchCooperativeKernel((void*)mega, dim3(grid), dim3(256), args, 0, stream);
    if (e != hipSuccess) fprintf(stderr, "cooperative launch failed: %s (grid %d)\n", hipGetErrorString(e), grid);
#endif
}
```

```cpp
#include <hip/hip_runtime.h>
#include <hip/hip_fp16.h>
#include <hip/hip_cooperative_groups.h>
#include <cstdio>
namespace cg = cooperative_groups;

#ifndef PHMASK
#define PHMASK 0x7ff
#endif
#define PHEN(k) ((PHMASK >> (k)) & 1)
#ifndef DUPMASK
#define DUPMASK 0
#endif
#define NREP(k) (((DUPMASK >> (k)) & 1) ? 2 : 1)
#ifndef MULTI_LAUNCH
#define MULTI_LAUNCH 0
#endif

typedef _Float16 h16;
typedef h16 h16x8 __attribute__((ext_vector_type(8)));
typedef h16 h16x4 __attribute__((ext_vector_type(4)));
typedef float f32x16 __attribute__((ext_vector_type(16)));
typedef float f32x4 __attribute__((ext_vector_type(4)));
__device__ __forceinline__ float4 nt_load4(const float* p) { const f32x4 v = __builtin_nontemporal_load((const f32x4*)p); return make_float4(v[0], v[1], v[2], v[3]); }
#define MFMA16(a, b, c) __builtin_amdgcn_mfma_f32_16x16x32_f16((a), (b), (c), 0, 0, 0)
#define DI __device__ __forceinline__
#define MFMA32(a, b, c) __builtin_amdgcn_mfma_f32_32x32x16_f16((a), (b), (c), 0, 0, 0)

constexpr int SEQ = 2048, NB = 8, TOK = NB * SEQ, DM = 1024;
constexpr float EPS = 1e-6f;
constexpr float LOG2E = 1.4426950408889634f;

constexpr size_t MiB = (size_t)1 << 20;
constexpr size_t OFF_CTR = 0;
constexpr size_t OFF_BAR = 16 * 1024;
constexpr size_t OFF_S5A = 64 * 1024;
constexpr size_t OFF_S5B = 128 * 1024;
constexpr size_t OFF_S5C = 512 * 1024;
constexpr size_t OFF_S5STEP = 1280 * 1024;
constexpr size_t OFF_ROWSS2 = 1472 * 1024;
constexpr size_t OFF_ROWSS3 = 1536 * 1024;
constexpr size_t OFF_ROWSS = 1408 * 1024;
constexpr size_t OFF_S5A128 = 1344 * 1024;
constexpr size_t OFF_S5E = 214 * ((size_t)1 << 20);
constexpr size_t OFF_KR = 2 * MiB;
constexpr size_t OFF_WOUT1 = 4 * MiB;
constexpr size_t OFF_OBUF = 8 * MiB;
constexpr size_t OFF_WIN0 = 72 * MiB;
constexpr size_t OFF_WGLU = 80 * MiB;
constexpr size_t OFF_WOUT0 = 89 * MiB;
constexpr size_t OFF_WMKV0 = 93 * MiB;
constexpr size_t OFF_WMKV1 = 95 * MiB;
constexpr size_t OFF_MEMK0 = 97 * MiB;
constexpr size_t OFF_MEMVT0 = 99 * MiB;
constexpr size_t OFF_U = 101 * MiB;
constexpr size_t OFF_XQ0 = 149 * MiB;
constexpr size_t OFF_XN0 = 165 * MiB;
constexpr size_t OFF_MEMN0 = 197 * MiB;
constexpr size_t OFF_MEMN1 = 201 * MiB;
constexpr size_t OFF_YG = 165 * MiB;
constexpr size_t OFF_MEMK1 = 250 * MiB;
constexpr size_t OFF_MEMVT1 = 252 * MiB;
constexpr size_t OFF_XN1 = 112 * MiB;
constexpr size_t OFF_WIN1 = 104 * MiB;
constexpr size_t OFF_Q = 72 * MiB;
constexpr size_t OFF_KN = 144 * MiB;
constexpr size_t OFF_VT = 192 * MiB;
constexpr size_t OFF_CQ = 144 * MiB;
constexpr size_t OFF_XQ1 = 160 * MiB;
constexpr size_t OFF_WUQ = 176 * MiB;
constexpr size_t OFF_CKV = 240 * MiB;
constexpr size_t OFF_WUKV = 248 * MiB;

constexpr int LDS_BYTES = 73728 + 1024;
constexpr int LDS_XB = 73728 + 768;
constexpr int LDS_RS = 73728;
constexpr int LDS_ITEM = 73728 + 512;

struct P {
    const float* x; const float* mem; const int* pos;
    const float* ln_gain; const float* w_out; const float* mem_norm; const float* w_mem_kv; const float* xq_norm; const float* xk_norm;
    const float* s5_w_in; const float* lam_re; const float* lam_im; const float* log_step;
    const float* b_re; const float* b_im; const float* c_re; const float* c_im; const float* s5_d; const float* w_glu;
    const float* mla_w_in; const float* q_lora_norm; const float* kv_lora_norm; const float* w_uq; const float* w_ukv;
    const float* q_nope_norm; const float* k_nope_norm; const float* q_rope_norm; const float* k_rope_norm;
    float* out; char* ws;
};

DI float wave_sum(float v) {
    v += __shfl_xor(v, 32); v += __shfl_xor(v, 16); v += __shfl_xor(v, 8);
    v += __shfl_xor(v, 4); v += __shfl_xor(v, 2); v += __shfl_xor(v, 1);
    return v;
}
DI float half_sum(float v) {
    v += __shfl_xor(v, 16); v += __shfl_xor(v, 8); v += __shfl_xor(v, 4); v += __shfl_xor(v, 2); v += __shfl_xor(v, 1);
    return v;
}
DI int crow(int i, int hf) { return (i & 3) + 8 * (i >> 2) + 4 * hf; }
DI int swap23(int m) { return (m & 0x13) | ((m & 4) << 1) | ((m & 8) >> 1); }
DI float sigmoidf_(float x) { return __builtin_amdgcn_rcpf(1.f + __expf(-x)); }
DI float siluf_(float x) { return x * sigmoidf_(x); }
DI float geluf_(float x) {
    const float z2 = 1.5957691216057308f * x * fmaf(0.044715f * x, x, 1.f);
    return x * __builtin_amdgcn_rcpf(1.f + __expf(-z2));
}

DI void rmsnorm_rows(const float* __restrict__ src, const float* __restrict__ gain, h16* __restrict__ dst, int nrows,
                     int wgid, int nw, int lane) {
    float4 v[4], vn[4];
    int r = wgid;
    if (r < nrows) {
#pragma unroll
        for (int i = 0; i < 4; ++i) v[i] = nt_load4(src + (size_t)r * DM + (lane + 64 * i) * 4);
    }
    for (; r < nrows; r += nw) {
        const int rn = r + nw;
        if (rn < nrows) {
#pragma unroll
            for (int i = 0; i < 4; ++i) vn[i] = nt_load4(src + (size_t)rn * DM + (lane + 64 * i) * 4);
        }
        float ss = 0.f;
#pragma unroll
        for (int i = 0; i < 4; ++i) ss += v[i].x * v[i].x + v[i].y * v[i].y + v[i].z * v[i].z + v[i].w * v[i].w;
        ss = wave_sum(ss);
        float rs = rsqrtf(ss * (1.f / DM) + EPS);
#pragma unroll
        for (int i = 0; i < 4; ++i) {
            float4 g = ((const float4*)gain)[lane + 64 * i];
            h16x4 o; o[0] = (h16)(v[i].x * rs * g.x); o[1] = (h16)(v[i].y * rs * g.y); o[2] = (h16)(v[i].z * rs * g.z); o[3] = (h16)(v[i].w * rs * g.w);
            *(h16x4*)(dst + (size_t)r * DM + (lane + 64 * i) * 4) = o;
        }
#pragma unroll
        for (int i = 0; i < 4; ++i) v[i] = vn[i];
    }
}

DI void conv_tile(const float* __restrict__ src, int Nsrc, int srccol0, h16* __restrict__ dst, int K, int dstrow0, int k0,
                  const float* __restrict__ kgain, float* tile, int tid) {
    __syncthreads();
    if (srccol0 >= 0) {
#pragma unroll
        for (int i = 0; i < 4; ++i) {
            int k = (tid >> 4) + 16 * i, n = (tid & 15) * 4;
            float4 v = nt_load4(src + (size_t)(k0 + k) * Nsrc + srccol0 + n);
            float g = kgain ? kgain[k0 + k] : 1.f;
            tile[k * 65 + n + 0] = v.x * g; tile[k * 65 + n + 1] = v.y * g; tile[k * 65 + n + 2] = v.z * g; tile[k * 65 + n + 3] = v.w * g;
        }
    }
    __syncthreads();
#pragma unroll
    for (int i = 0; i < 2; ++i) {
        int c = tid + 256 * i, n = c >> 3, kc = c & 7;
        h16x8 o;
#pragma unroll
        for (int e = 0; e < 8; ++e) o[e] = (srccol0 >= 0) ? (h16)tile[(kc * 8 + e) * 65 + n] : (h16)0.f;
        *(h16x8*)(dst + (size_t)(dstrow0 + n) * K + k0 + kc * 8) = o;
    }
}

DI int conv_matrix(const P& p, int mat, int bid, int nblk, float* tile, int tid, int rot = 0) {
    const float* src; int Nsrc, K, Nd; h16* dst; const float* kg = nullptr;
    switch (mat) {
        case 0: src = p.s5_w_in; Nsrc = 4096; K = 1024; Nd = 4096; dst = (h16*)(p.ws + OFF_WIN0); break;
        case 1: src = p.w_glu; Nsrc = 3072; K = 1536; Nd = 3072; dst = (h16*)(p.ws + OFF_WGLU); break;
        case 2: src = p.w_out; Nsrc = 1024; K = 2048; Nd = 1024; dst = (h16*)(p.ws + OFF_WOUT0); break;
        case 3: src = p.w_out + (size_t)2048 * 1024; Nsrc = 1024; K = 2048; Nd = 1024; dst = (h16*)(p.ws + OFF_WOUT1); break;
        case 4: src = p.w_mem_kv; Nsrc = 1024; K = 1024; Nd = 1024; dst = (h16*)(p.ws + OFF_WMKV0); break;
        case 5: src = p.w_mem_kv + (size_t)1024 * 1024; Nsrc = 1024; K = 1024; Nd = 1024; dst = (h16*)(p.ws + OFF_WMKV1); break;
        case 6: src = p.w_ukv; Nsrc = 3072; K = 256; Nd = 3072; dst = (h16*)(p.ws + OFF_WUKV); kg = p.kv_lora_norm; break;
        case 7: src = p.mla_w_in; Nsrc = 3392; K = 1024; Nd = 3456; dst = (h16*)(p.ws + OFF_WIN1); kg = p.ln_gain + DM; break;
        default: src = p.w_uq; Nsrc = 2304; K = 512; Nd = 2304; dst = (h16*)(p.ws + OFF_WUQ); kg = p.q_lora_norm; break;
    }
    const int nkt = K / 64, nitems = (Nd / 64) * nkt;
    for (int it = (bid + nblk - rot % nblk) % nblk; it < nitems; it += nblk) {
        int nt = it / nkt, kt = it % nkt;
        int n0 = nt * 64, sc = n0;
        if (mat == 1) { int t128 = n0 >> 7, half = (n0 >> 6) & 1; sc = (half ? 1536 : 0) + t128 * 64; }
        else if (mat == 7) {
            if (n0 < 768) sc = n0;
            else if (n0 < 1280) sc = 832 + (n0 - 768);
            else if (n0 < 3328) sc = 1344 + (n0 - 1280);
            else if (n0 < 3392) sc = 768 + (n0 - 3328);
            else sc = -1;
        } else if (mat == 8) {
            if (n0 < 1536) { int h = n0 >> 7; sc = h * 192 + (n0 & 127); }
            else { int h = (n0 - 1536) >> 6; sc = h * 192 + 128; }
        }
        conv_tile(src, Nsrc, sc, dst, K, n0, kt * 64, kg, tile, tid);
    }
    return nitems;
}

DI void s5_tables(const P& p, int gtid, int nthreads) {
    float* At = (float*)(p.ws + OFF_S5A);
    h16* Bt = (h16*)(p.ws + OFF_S5B);
    h16* Ct = (h16*)(p.ws + OFF_S5C);
    float* St = (float*)(p.ws + OFF_S5STEP);
    for (int idx2 = gtid; idx2 < 96 * 64 * 16; idx2 += nthreads) {
        const int idx = idx2 >> 4, c = idx2 & 15;
        const int g = idx >> 6, pp = idx & 63;
        const float step = expf(p.log_step[g]);
        const float lr = p.lam_re[idx], li = p.lam_im[idx];
        const float xr = lr * step, yi = li * step;
        float sy, cy; sincosf(yi, &sy, &cy);
        const float ex = expf(xr);
        const float are = ex * cy, aim = ex * sy;
        const float sh = sinf(0.5f * yi);
        const float nre = expm1f(xr) * cy - 2.f * sh * sh;
        const float nim = aim;
        const float den = (lr * lr + li * li) * step;
        const float cre = (nre * lr + nim * li) / den;
        const float cim = (nim * lr - nre * li) / den;
        if (c == 0) {
            At[idx * 2] = are; At[idx * 2 + 1] = aim;
            float s128, c128; sincosf(128.f * yi, &s128, &c128);
            const float e128 = expf(128.f * xr);
            float* A128 = (float*)(p.ws + OFF_S5A128);
            A128[idx * 2] = e128 * c128; A128[idx * 2 + 1] = e128 * s128;
            if (pp == 0) St[g] = step;
        }
        const int q = pp & 31, jj = pp >> 5;
        const float br = p.b_re[(size_t)idx * 16 + c], bi = p.b_im[(size_t)idx * 16 + c];
        Bt[((size_t)g * 128 + 32 * jj + q) * 16 + c] = (h16)(cre * br - cim * bi);
        Bt[((size_t)g * 128 + 32 * (2 + jj) + q) * 16 + c] = (h16)(cre * bi + cim * br);
        const float cs = step * 1024.f;
        const float cr = p.c_re[((size_t)g * 16 + c) * 64 + pp], ci = p.c_im[((size_t)g * 16 + c) * 64 + pp];
        Ct[((size_t)g * 16 + c) * 128 + 4 * q + jj] = (h16)(cr * cs);
        Ct[((size_t)g * 16 + c) * 128 + 4 * q + 2 + jj] = (h16)(-ci * cs);
    }
}

template <bool SWAP>
DI void gemm_tile(const h16* __restrict__ A, int lda, const h16* __restrict__ B, int ldb, int K, char* lds, f32x16 (&acc)[4], int tid) {
    const int lane = tid & 63, wave = __builtin_amdgcn_readfirstlane(tid >> 6), q = lane & 31, hf = lane >> 5;
#pragma unroll
    for (int j = 0; j < 4; ++j)
#pragma unroll
        for (int i = 0; i < 16; ++i) acc[j][i] = 0.f;
    const int nk = K >> 6;
    const h16* src[8];
    {
        const int rl = lane >> 3;
#pragma unroll
        for (int i = 0; i < 8; ++i) {
            const int r = 8 * (wave * 8 + i) + rl;
            const int c = (lane & 7) ^ ((4 * (i & 1) + (lane >> 4)) & 7);
            src[i] = (r < 128) ? A + (size_t)r * lda + c * 8 : B + (size_t)(r - 128) * ldb + c * 8;
        }
    }
    const int xs = (q >> 1) & 7;
    int fo[4];
#pragma unroll
    for (int kk = 0; kk < 4; ++kk) fo[kk] = q * 128 + (((kk * 2 + hf) ^ xs) << 4);
#define G_GLDS(stage_, k0_)                                                                                           \
    _Pragma("unroll") for (int i = 0; i < 8; ++i)                                                                     \
        __builtin_amdgcn_global_load_lds((const unsigned*)(src[i] + (k0_)), (unsigned*)(lds + (stage_) * 32768 + (wave * 8 + i) * 1024), 16, 0, 0);
#define G_FRAG(buf_, kk_, FA, FB)                                                                                     \
    FA = *(const h16x8*)(lds + (buf_) * 32768 + wave * (32 * 128) + fo[kk_]);                                         \
    _Pragma("unroll") for (int j = 0; j < 4; ++j)                                                                     \
        FB[j] = *(const h16x8*)(lds + (buf_) * 32768 + 16384 + j * (32 * 128) + fo[kk_]);
#define G_MMA(FA, FB) _Pragma("unroll") for (int j = 0; j < 4; ++j) acc[j] = SWAP ? MFMA32(FB[j], FA, acc[j]) : MFMA32(FA, FB[j], acc[j]);
#define G_STEP(buf_, kload_)                                                                                          \
    {                                                                                                                 \
        h16x8 fa0, fb0[4], fa1, fb1[4];                                                                               \
        asm volatile("s_waitcnt vmcnt(0)" ::: "memory");                                                              \
        __syncthreads();                                                                                              \
        G_GLDS((buf_) ^ 1, kload_);                                                                                   \
        G_FRAG(buf_, 0, fa0, fb0);                                                                                    \
        G_FRAG(buf_, 1, fa1, fb1);                                                                                    \
        __builtin_amdgcn_sched_barrier(0);                                                                            \
        G_MMA(fa0, fb0);                                                                                              \
        __builtin_amdgcn_sched_barrier(0);                                                                            \
        G_FRAG(buf_, 2, fa0, fb0);                                                                                    \
        __builtin_amdgcn_sched_barrier(0);                                                                            \
        G_MMA(fa1, fb1);                                                                                              \
        __builtin_amdgcn_sched_barrier(0);                                                                            \
        G_FRAG(buf_, 3, fa1, fb1);                                                                                    \
        __builtin_amdgcn_sched_barrier(0);                                                                            \
        G_MMA(fa0, fb0);                                                                                              \
        G_MMA(fa1, fb1);                                                                                              \
    }
    __syncthreads();
    G_GLDS(0, 0);
    const int klast = (nk - 1) << 6;
    for (int kt = 0; kt < nk; kt += 2) {
        { const int k0 = min((kt + 1) << 6, klast); G_STEP(0, k0); }
        { const int k1 = min((kt + 2) << 6, klast); G_STEP(1, k1); }
    }
    asm volatile("s_waitcnt vmcnt(0)" ::: "memory");
#undef G_GLDS
#undef G_FRAG
#undef G_MMA
#undef G_STEP
}

template <bool SWAP, bool AGM = false>
DI void gemm_tile256(const h16* __restrict__ A, int lda, const h16* __restrict__ B, int ldb, int K, char* lds, f32x16 (&acc)[2][4], int tid) {
    const int lane = tid & 63, wave = __builtin_amdgcn_readfirstlane(tid >> 6), q = lane & 31, hf = lane >> 5;
#pragma unroll
    for (int hh = 0; hh < 2; ++hh)
#pragma unroll
        for (int j = 0; j < 4; ++j)
#pragma unroll
            for (int i = 0; i < 16; ++i) acc[hh][j][i] = 0.f;
    const int nk = K >> 5;
    const h16* src[6];
    {
        const int rl = lane >> 2, c = (lane & 3) ^ ((lane >> 4) & 3);
#pragma unroll
        for (int i = 0; i < 6; ++i) {
            const int r = 16 * (wave * 6 + i) + rl;
            if (AGM) src[i] = (r < 256) ? A + (size_t)(c >> 1) * TOK * 16 + (size_t)r * 16 + 8 * (c & 1) : B + (size_t)(r - 256) * ldb + c * 8;
            else src[i] = (r < 256) ? A + (size_t)r * lda + c * 8 : B + (size_t)(r - 256) * ldb + c * 8;
        }
    }
#define T_KOFF(i_, k0_) ((AGM && (16 * (wave * 6 + (i_)) < 256)) ? (size_t)(k0_) * TOK : (size_t)(k0_))
    const int xs = (q >> 2) & 3;
    const int fo0 = q * 64 + ((hf ^ xs) << 4), fo1 = q * 64 + (((2 + hf) ^ xs) << 4);
#define T_GLDS(stage_, k0_)                                                                                           \
    _Pragma("unroll") for (int i = 0; i < 6; ++i)                                                                     \
        __builtin_amdgcn_global_load_lds((const unsigned*)(src[i] + T_KOFF(i, k0_)), (unsigned*)(lds + (stage_) * 24576 + (wave * 6 + i) * 1024), 16, 0, 0);
#define T_STEP(buf_, kload_)                                                                                          \
    {                                                                                                                 \
        h16x8 fa[2][2], fb[2][4];                                                                                     \
        asm volatile("s_waitcnt vmcnt(0)" ::: "memory");                                                              \
        __syncthreads();                                                                                              \
        _Pragma("unroll") for (int hh = 0; hh < 2; ++hh) fa[0][hh] = *(const h16x8*)(lds + (buf_) * 24576 + (wave * 64 + hh * 32) * 64 + fo0); \
        _Pragma("unroll") for (int j = 0; j < 4; ++j) fb[0][j] = *(const h16x8*)(lds + (buf_) * 24576 + 16384 + (j * 32) * 64 + fo0); \
        __builtin_amdgcn_sched_barrier(0);                                                                            \
        T_GLDS((buf_) ^ 1, kload_);                                                                                   \
        _Pragma("unroll") for (int hh = 0; hh < 2; ++hh) fa[1][hh] = *(const h16x8*)(lds + (buf_) * 24576 + (wave * 64 + hh * 32) * 64 + fo1); \
        _Pragma("unroll") for (int j = 0; j < 4; ++j) fb[1][j] = *(const h16x8*)(lds + (buf_) * 24576 + 16384 + (j * 32) * 64 + fo1); \
        _Pragma("unroll") for (int kk = 0; kk < 2; ++kk)                                                              \
            _Pragma("unroll") for (int hh = 0; hh < 2; ++hh)                                                          \
                _Pragma("unroll") for (int j = 0; j < 4; ++j) acc[hh][j] = SWAP ? MFMA32(fb[kk][j], fa[kk][hh], acc[hh][j]) : MFMA32(fa[kk][hh], fb[kk][j], acc[hh][j]); \
    }
    __syncthreads();
    T_GLDS(0, 0);
    const int klast = (nk - 1) << 5;
    for (int kt = 0; kt < nk; kt += 2) {
        { const int k0 = min((kt + 1) << 5, klast); T_STEP(0, k0); }
        { const int k1 = min((kt + 2) << 5, klast); T_STEP(1, k1); }
    }
    asm volatile("s_waitcnt vmcnt(0)" ::: "memory");
#undef T_GLDS
#undef T_STEP
#undef T_KOFF
}
DI bool tile_map256(int bid, int nblk, int it, int NT, int& mt, int& nt) {
    const int x = bid & 7, li = bid >> 3, nper = nblk >> 3;
    const int n = li + it * nper;
    if (n >= 8 * NT) return false;
    mt = x * 8 + (n / (4 * NT)) * 4 + (n & 3);
    nt = (n >> 2) % NT;
    return true;
}

DI void row_scales(const h16* __restrict__ A, int K, int m0, char* lds, int tid) {
    __syncthreads();
    const int row = tid >> 1, half = tid & 1, n = K >> 1;
    const h16* ap = A + (size_t)(m0 + row) * K + half * n;
    float ss = 0.f;
    for (int c = 0; c < n; c += 8) {
        h16x8 v = *(const h16x8*)(ap + c);
#pragma unroll
        for (int e = 0; e < 8; ++e) { float f = (float)v[e]; ss += f * f; }
    }
    ss += __shfl_xor(ss, 1);
    if (half == 0) ((float*)(lds + LDS_RS))[row] = rsqrtf(ss / (float)K + EPS);
    __syncthreads();
}

DI void epi_store(const f32x16 (&acc)[4], h16* __restrict__ dst, int ld, int mrow0, int col0, int q, int hf) {
#pragma unroll
    for (int i = 0; i < 16; ++i) {
        h16* rp = dst + (size_t)(mrow0 + crow(i, hf)) * ld + col0 + q;
#pragma unroll
        for (int j = 0; j < 4; ++j) rp[32 * j] = (h16)acc[j][i];
    }
}
DI void epi_norm128(const f32x16 (&acc)[4], const float* __restrict__ gain, const float* rs, int rsrow0, h16* __restrict__ dst, size_t rowstride,
                    int q, int hf) {
    float g[4];
#pragma unroll
    for (int j = 0; j < 4; ++j) g[j] = gain[32 * j + q];
    const float* rsb = rs ? rs + rsrow0 + 4 * hf : nullptr;
    dst += (size_t)(4 * hf) * rowstride;
#pragma unroll
    for (int i = 0; i < 16; ++i) {
        const int r = (i & 3) + 8 * (i >> 2);
        const float pre = rsb ? rsb[r] : 1.f;
        float v[4]; float ss = 0.f;
#pragma unroll
        for (int j = 0; j < 4; ++j) { v[j] = acc[j][i] * pre; ss += v[j] * v[j]; }
        ss = half_sum(ss);
        const float sc = rsqrtf(ss * (1.f / 128.f) + EPS);
        h16* rp = dst + (size_t)r * rowstride + q;
#pragma unroll
        for (int j = 0; j < 4; ++j) rp[32 * j] = (h16)(v[j] * sc * g[j]);
    }
}

DI void fast_sincos(float x, float& s, float& c) {
    const float k = rintf(x * 0.15915494309189535f);
    float r = fmaf(-k, 6.28125f, x);
    r = fmaf(-k, 0.0019353071795864769f, r);
    s = __sinf(r); c = __cosf(r);
}
DI void t_store(const f32x16 (&acc)[4], h16* __restrict__ rowp, int hf, float pre) {
#pragma unroll
    for (int j = 0; j < 4; ++j)
#pragma unroll
        for (int g4 = 0; g4 < 4; ++g4) {
            h16x4 v;
#pragma unroll
            for (int e = 0; e < 4; ++e) v[e] = (h16)(acc[j][4 * g4 + e] * pre);
            *(h16x4*)(rowp + 32 * j + 8 * g4 + 4 * hf) = v;
        }
}
DI void t_silu_store(const f32x16 (&acc)[4], h16* __restrict__ rowp, int hf) {
#pragma unroll
    for (int j = 0; j < 4; ++j)
#pragma unroll
        for (int g4 = 0; g4 < 4; ++g4) {
            h16x4 v;
#pragma unroll
            for (int e = 0; e < 4; ++e) v[e] = (h16)siluf_(acc[j][4 * g4 + e]);
            *(h16x4*)(rowp + 32 * j + 8 * g4 + 4 * hf) = v;
        }
}
DI void t_norm128(const f32x16 (&acc)[4], float pre, h16* __restrict__ rowp, int hf) {
    float ss = 0.f;
#pragma unroll
    for (int j = 0; j < 4; ++j)
#pragma unroll
        for (int i = 0; i < 16; ++i) { const float v = acc[j][i] * pre; ss += v * v; }
    ss += __shfl_xor(ss, 32);
    const float sc = rsqrtf(ss * (1.f / 128.f) + EPS) * pre;
    t_store(acc, rowp, hf, sc);
}
DI void wave_lds_fence() {
    asm volatile("s_waitcnt lgkmcnt(0)" ::: "memory");
    __builtin_amdgcn_wave_barrier();
}
DI void t_flush128(const char* stg, h16* __restrict__ dst, int ld, int lane) {
    wave_lds_fence();
#pragma unroll
    for (int r4 = 0; r4 < 8; ++r4) {
        const int row = 4 * r4 + (lane >> 4), c = lane & 15;
        const h16x8 x = *(const h16x8*)(stg + row * 272 + c * 16);
        *(h16x8*)(dst + (size_t)row * ld + c * 8) = x;
    }
    wave_lds_fence();
}
DI void t_flush128g(const char* stg, h16* __restrict__ dst, int ld, const float* __restrict__ gain, int lane) {
    wave_lds_fence();
    const int c = lane & 15;
    const float4 g0 = *(const float4*)(gain + c * 8), g1 = *(const float4*)(gain + c * 8 + 4);
#pragma unroll
    for (int r4 = 0; r4 < 8; ++r4) {
        const int row = 4 * r4 + (lane >> 4);
        const h16x8 x = *(const h16x8*)(stg + row * 272 + c * 16);
        h16x8 o;
        o[0] = (h16)((float)x[0] * g0.x); o[1] = (h16)((float)x[1] * g0.y); o[2] = (h16)((float)x[2] * g0.z); o[3] = (h16)((float)x[3] * g0.w);
        o[4] = (h16)((float)x[4] * g1.x); o[5] = (h16)((float)x[5] * g1.y); o[6] = (h16)((float)x[6] * g1.z); o[7] = (h16)((float)x[7] * g1.w);
        *(h16x8*)(dst + (size_t)row * ld + c * 8) = o;
    }
    wave_lds_fence();
}
DI void t_flush128_mul(const char* stg, h16* __restrict__ dst, int ld, int lane) {
    wave_lds_fence();
    const int c = lane & 15;
    h16x8 sg[8];
#pragma unroll
    for (int r4 = 0; r4 < 8; ++r4) sg[r4] = *(const h16x8*)(dst + (size_t)(4 * r4 + (lane >> 4)) * ld + c * 8);
#pragma unroll
    for (int r4 = 0; r4 < 8; ++r4) {
        const int row = 4 * r4 + (lane >> 4);
        const h16x8 x = *(const h16x8*)(stg + row * 272 + c * 16);
        h16x8 o;
#pragma unroll
        for (int e = 0; e < 8; ++e) o[e] = (h16)((float)x[e] * (float)sg[r4][e]);
        *(h16x8*)(dst + (size_t)row * ld + c * 8) = o;
    }
    wave_lds_fence();
}
DI void t_flush64(const char* stg, h16* __restrict__ dst, int ld, int lane) {
    wave_lds_fence();
#pragma unroll
    for (int r4 = 0; r4 < 4; ++r4) {
        const int row = 8 * r4 + (lane >> 3), c = lane & 7;
        const h16x8 x = *(const h16x8*)(stg + row * 272 + c * 16);
        *(h16x8*)(dst + (size_t)row * ld + c * 8) = x;
    }
    wave_lds_fence();
}
DI void t_flush64_mul(const char* stg, h16* __restrict__ dst, int ld, int lane) {
    wave_lds_fence();
    h16x8 sg[4];
#pragma unroll
    for (int r4 = 0; r4 < 4; ++r4) sg[r4] = *(const h16x8*)(dst + (size_t)(8 * r4 + (lane >> 3)) * ld + (lane & 7) * 8);
#pragma unroll
    for (int r4 = 0; r4 < 4; ++r4) {
        const int row = 8 * r4 + (lane >> 3), c = lane & 7;
        const h16x8 x = *(const h16x8*)(stg + row * 272 + c * 16);
        h16x8 o;
#pragma unroll
        for (int e = 0; e < 8; ++e) o[e] = (h16)((float)x[e] * (float)sg[r4][e]);
        *(h16x8*)(dst + (size_t)row * ld + c * 8) = o;
    }
    wave_lds_fence();
}
DI void t_flush_gm(const char* stg, h16* __restrict__ dst  , int lane) {
    wave_lds_fence();
    const int row = lane >> 1, half = lane & 1;
#pragma unroll
    for (int k = 0; k < 8; ++k) {
        const h16x8 x = *(const h16x8*)(stg + row * 272 + k * 32 + half * 16);
        *(h16x8*)(dst + (size_t)k * TOK * 16 + row * 16 + half * 8) = x;
    }
    wave_lds_fence();
}
DI void t_rowss(const f32x16 (&acc)[4], float pre, float* __restrict__ ssum_tok, int hf) {
    float ss = 0.f;
#pragma unroll
    for (int j = 0; j < 4; ++j)
#pragma unroll
        for (int i = 0; i < 16; ++i) { const float v = acc[j][i] * pre; ss += v * v; }
    ss += __shfl_xor(ss, 32);
    if (hf == 0) atomicAdd(ssum_tok, ss);
}
DI void t_epi(const f32x16 (&acc)[4], int mode, const float* gain, float pre, char* stg, h16* __restrict__ dst, int ld, int q, int hf, int lane) {
    float sc = pre;
    if (mode == 1) {
        float ss = 0.f;
#pragma unroll
        for (int j = 0; j < 4; ++j)
#pragma unroll
            for (int i = 0; i < 16; ++i) { const float v = acc[j][i] * pre; ss += v * v; }
        ss += __shfl_xor(ss, 32);
        sc = rsqrtf(ss * (1.f / 128.f) + EPS) * pre;
    }
    h16* srow = (h16*)(stg + q * 272) + 4 * hf;
#pragma unroll
    for (int j = 0; j < 4; ++j)
#pragma unroll
        for (int g4 = 0; g4 < 4; ++g4) {
            h16x4 v;
            if (mode == 2) {
#pragma unroll
                for (int e = 0; e < 4; ++e) v[e] = (h16)siluf_(acc[j][4 * g4 + e] * pre);
            } else {
#pragma unroll
                for (int e = 0; e < 4; ++e) v[e] = (h16)(acc[j][4 * g4 + e] * sc);
            }
            *(h16x4*)(srow + 32 * j + 8 * g4) = v;
        }
    if (mode == 1) t_flush128g(stg, dst, ld, gain, lane);
    else if (ld == 0) t_flush_gm(stg, dst, lane);
    else t_flush128(stg, dst, ld, lane);
}
DI void t_rope64(const f32x16& a0, const f32x16& a1, const float* __restrict__ gain, float pre, float posf, h16* __restrict__ rowp, int hf) {
    float ss = 0.f;
#pragma unroll
    for (int i = 0; i < 16; ++i) { const float v0 = a0[i] * pre, v1 = a1[i] * pre; ss += v0 * v0 + v1 * v1; }
    ss += __shfl_xor(ss, 32);
    const float sc = rsqrtf(ss * (1.f / 64.f) + EPS) * pre;
#pragma unroll
    for (int g4 = 0; g4 < 4; ++g4) {
        h16x4 o1, o2;
#pragma unroll
        for (int e = 0; e < 4; ++e) {
            const int d = 8 * g4 + 4 * hf + e;
            const float invf = exp2f(-(float)d * 0.41524101186092029f);
            float sn, cs; fast_sincos(posf * invf, sn, cs);
            const float x1 = a0[4 * g4 + e] * sc * gain[d], x2 = a1[4 * g4 + e] * sc * gain[32 + d];
            o1[e] = (h16)(x1 * cs - x2 * sn); o2[e] = (h16)(x1 * sn + x2 * cs);
        }
        *(h16x4*)(rowp + 8 * g4 + 4 * hf) = o1;
        *(h16x4*)(rowp + 32 + 8 * g4 + 4 * hf) = o2;
    }
}

template <int DK, bool CAUSAL>
DI void attn_item(const h16* __restrict__ Qb, int qstride, const h16* __restrict__ Kn, int knstride, const h16* __restrict__ Kr,
                  const h16* __restrict__ Vt, int vtstride, int vtile, int nkt, int q0, h16* __restrict__ outb, int ostride, float sc,
                  char* lds, int tid) {
    constexpr int KSTR = (DK + 8) * 2;
    constexpr int CPK = DK / 8;
    constexpr int NKC = 64 * CPK / 256;
    constexpr int NKS = DK / 16;
    char* Ks = lds; char* Vs = lds + 64 * KSTR;
    const int lane = tid & 63, wave = __builtin_amdgcn_readfirstlane(tid >> 6), q = lane & 31, hf = lane >> 5;
    h16x8 qf[NKS];
#pragma unroll
    for (int ks = 0; ks < NKS; ++ks) qf[ks] = *(const h16x8*)(Qb + (size_t)(wave * 32 + q) * qstride + 16 * ks + 8 * hf);
    h16x8 kreg[NKC];
    f32x16 o[4];
#pragma unroll
    for (int j = 0; j < 4; ++j)
#pragma unroll
        for (int i = 0; i < 16; ++i) o[j][i] = 0.f;
    float m_run = -1e30f, l_run = 0.f;
    const int qw0 = q0 + wave * 32, qglob = qw0 + q;
    const int sq = swap23(q);

    const int tk_off = (tid >> 4) * knstride + (tid & 15) * 8;
    const int tr_off = (tid >> 3) * 64 + (tid & 7) * 8;
    const int vrow = 32 * wave + (lane >> 3);
    const int voff_e = vrow * vtstride + (((lane & 7) ^ (lane >> 4)) << 3);
    const int voff_o = (vrow + 8) * vtstride + (((lane & 7) ^ ((4 + (lane >> 4)) & 7)) << 3);
    const int vxs = (q >> 1) & 7;
    const int lk_off = (tid >> 4) * KSTR + (tid & 15) * 16;
    const int lr_off = (tid >> 3) * KSTR + 256 + (tid & 7) * 16;
#define ATT_LOAD(kt_)                                                                                                 \
    {                                                                                                                 \
        const h16* knp = Kn + (size_t)((kt_) * 64) * knstride;                                                        \
        _Pragma("unroll") for (int i = 0; i < 4; ++i) kreg[i] = *(const h16x8*)(knp + (16 * i) * knstride + tk_off);  \
        if (DK == 192) {                                                                                              \
            const h16* krp = Kr + (size_t)((kt_) * 64) * 64;                                                          \
            _Pragma("unroll") for (int i = 0; i < NKC - 4; ++i) kreg[4 + i] = *(const h16x8*)(krp + (32 * i) * 64 + tr_off); \
        }                                                                                                             \
        const h16* vp = Vt + (size_t)(kt_) * vtile;                                                                   \
        _Pragma("unroll") for (int i = 0; i < 4; ++i)                                                                 \
            __builtin_amdgcn_global_load_lds((const unsigned*)(vp + ((i & 1) ? voff_o : voff_e) + (i >> 1) * 16 * vtstride), (unsigned*)(Vs + ((kt_) & 1) * 16384 + (wave * 4 + i) * 1024), 16, 0, 0); \
    }
    ATT_LOAD(0);
    for (int kt = 0; kt < nkt; ++kt) {
        __syncthreads();
#pragma unroll
        for (int i = 0; i < 4; ++i) *(h16x8*)(Ks + lk_off + (16 * i) * KSTR) = kreg[i];
        if (DK == 192) {
#pragma unroll
            for (int i = 0; i < NKC - 4; ++i) *(h16x8*)(Ks + lr_off + (32 * i) * KSTR) = kreg[4 + i];
        }
        asm volatile("s_waitcnt vmcnt(0)" ::: "memory");
        __syncthreads();
        if (kt + 1 < nkt) ATT_LOAD(kt + 1);
        const bool skip = CAUSAL && (64 * kt > qw0 + 31);
        if (!skip) {
            f32x16 s0, s1;
#pragma unroll
            for (int i = 0; i < 16; ++i) { s0[i] = 0.f; s1[i] = 0.f; }
#pragma unroll
            for (int ks = 0; ks < NKS; ++ks) {
                h16x8 k0 = *(const h16x8*)(Ks + sq * KSTR + (16 * ks + 8 * hf) * 2);
                h16x8 k1 = *(const h16x8*)(Ks + (32 + sq) * KSTR + (16 * ks + 8 * hf) * 2);
                s0 = MFMA32(k0, qf[ks], s0);
                s1 = MFMA32(k1, qf[ks], s1);
            }
            const bool needmask = CAUSAL && (64 * kt + 63 > qw0);
            float mx = -1e30f;
            if (needmask) {
#pragma unroll
                for (int i = 0; i < 16; ++i) {
                    const int key = kt * 64 + 16 * (i >> 3) + 8 * hf + (i & 7);
                    if (key > qglob) s0[i] = -1e30f;
                    if (key + 32 > qglob) s1[i] = -1e30f;
                }
            }
#pragma unroll
            for (int i = 0; i < 16; ++i) mx = fmaxf(mx, fmaxf(s0[i], s1[i]));
            mx = fmaxf(mx, __shfl_xor(mx, 32));
            const float mnew = fmaxf(m_run, mx);
            const float alpha = __builtin_amdgcn_exp2f((m_run - mnew) * sc);
            m_run = mnew;
            const float msc = mnew * sc;
            float rsum = 0.f;
#pragma unroll
            for (int i = 0; i < 16; ++i) {
                float p0 = __builtin_amdgcn_exp2f(fmaf(s0[i], sc, -msc)), p1 = __builtin_amdgcn_exp2f(fmaf(s1[i], sc, -msc));
                s0[i] = p0; s1[i] = p1; rsum += p0 + p1;
            }
            l_run = l_run * alpha + rsum;
            if (__builtin_amdgcn_ballot_w64(alpha != 1.f) != 0ull) {
#pragma unroll
                for (int j = 0; j < 4; ++j)
#pragma unroll
                    for (int i = 0; i < 16; ++i) o[j][i] *= alpha;
            }
#pragma unroll
            for (int t2 = 0; t2 < 4; ++t2) {
                h16x8 pf;
#pragma unroll
                for (int e = 0; e < 8; ++e) pf[e] = (h16)((t2 < 2) ? s0[8 * (t2 & 1) + e] : s1[8 * (t2 & 1) + e]);
#pragma unroll
                for (int j = 0; j < 4; ++j) {
                    h16x8 vf = *(const h16x8*)(Vs + (kt & 1) * 16384 + (32 * j + q) * 128 + (((2 * t2 + hf) ^ vxs) << 4));
                    o[j] = MFMA32(vf, pf, o[j]);
                }
            }
        }
    }
#undef ATT_LOAD
    const float l = l_run + __shfl_xor(l_run, 32);
    const float inv = 1.f / l;
    __syncthreads();
    {
        char* stg = lds + wave * 8704;
        t_store(o, (h16*)(stg + q * 272), hf, inv);
        t_flush128_mul(stg, outb + (size_t)(wave * 32) * ostride, ostride, lane);
    }
}

DI void mem_attn_phase(const P& p, int layer, int* ctr, char* lds, int tid) {
    const h16* xq = (const h16*)(p.ws + (layer ? OFF_XQ1 : OFF_XQ0));
    const h16* mk = (const h16*)(p.ws + (layer ? OFF_MEMK1 : OFF_MEMK0));
    const h16* mvt = (const h16*)(p.ws + (layer ? OFF_MEMVT1 : OFF_MEMVT0));
    h16* obuf = (h16*)(p.ws + OFF_OBUF);
    volatile int* sitem = (volatile int*)(lds + LDS_ITEM);
    const float sc = 0.08838834764831845f * LOG2E;
    for (;;) {
        __syncthreads();
        if (tid == 0) *sitem = atomicAdd(ctr, 1);
        __syncthreads();
        const int it = *sitem;
        if (it >= 512) break;
        const int b = it >> 6, h = (it >> 4) & 3, qt = it & 15;
        const size_t row0 = (size_t)b * SEQ + qt * 128;
        attn_item<128, false>(xq + row0 * 512 + h * 128, 512, mk + (size_t)((b * 4 + h) * 256) * 128, 128, nullptr,
                              mvt + (size_t)((b * 4 + h) * 128) * 256, 256, 64, 4, 0, obuf + row0 * 2048 + 1536 + h * 128, 2048, sc, lds, tid);
    }
}

template <bool FULL>
DI void s5_seg(const P& p, int g, int bp, int s, char* ldsw, int lane) {
    const h16* u = (const h16*)(p.ws + OFF_U);
    h16* yg = (h16*)(p.ws + OFF_YG);
    const float* At = (const float*)(p.ws + OFF_S5A);
    const h16* Bt = (const h16*)(p.ws + OFF_S5B);
    const h16* Ct = (const h16*)(p.ws + OFF_S5C);
    float4* E = (float4*)(p.ws + OFF_S5E);
    const int q = lane & 31, hf = lane >> 5, c16 = lane & 15, l4 = lane >> 4;
    h16x8 bfr[4];
#pragma unroll
    for (int j = 0; j < 4; ++j) bfr[j] = *(const h16x8*)(Bt + ((size_t)g * 128 + 32 * j + q) * 16 + 8 * hf);
    const float are0 = At[(g * 64 + q) * 2], aim0 = At[(g * 64 + q) * 2 + 1];
    const float are1 = At[(g * 64 + q + 32) * 2], aim1 = At[(g * 64 + q + 32) * 2 + 1];
    float hr0 = 0.f, hi0 = 0.f, hr1 = 0.f, hi1 = 0.f;
    const size_t eidx = (size_t)((g * 4 + bp) * 16) * 64 + hf * 32 + q;
    h16x8 cfr[4];
    float dq = 0.f;
    if (FULL) {
#pragma unroll
        for (int ks = 0; ks < 4; ++ks) cfr[ks] = *(const h16x8*)(Ct + ((size_t)g * 16 + c16) * 128 + 32 * ks + 8 * l4);
        dq = 0.f;
        const float* A128 = (const float*)(p.ws + OFF_S5A128);
        const float pr0 = A128[(g * 64 + q) * 2], pi0 = A128[(g * 64 + q) * 2 + 1];
        const float pr1 = A128[(g * 64 + q + 32) * 2], pi1 = A128[(g * 64 + q + 32) * 2 + 1];
        for (int j = 0; j < s; ++j) {
            const float4 e = E[eidx + (size_t)j * 64];
            const float nr0 = fmaf(pr0, hr0, fmaf(-pi0, hi0, e.x)), ni0 = fmaf(pr0, hi0, fmaf(pi0, hr0, e.z));
            const float nr1 = fmaf(pr1, hr1, fmaf(-pi1, hi1, e.y)), ni1 = fmaf(pr1, hi1, fmaf(pi1, hr1, e.w));
            hr0 = nr0; hi0 = ni0; hr1 = nr1; hi1 = ni1;
        }
    }
    const int aseq = (q >> 2) & 1, att = (q & 3) + 4 * (q >> 3);
    const h16* ua = u + (size_t)g * TOK * 16 + ((size_t)(2 * bp + aseq) * SEQ + s * 128 + att) * 16 + 8 * hf;
    const float4 d4 = FULL ? *(const float4*)(p.s5_d + g * 16 + 4 * l4) : make_float4(0.f, 0.f, 0.f, 0.f);
    char* us = ldsw + 8704;
    h16x8 afn = *(const h16x8*)ua;
    for (int ch = 0; ch < 8; ++ch) {
        const h16x8 af = afn;
        if (ch + 1 < 8) afn = *(const h16x8*)(ua + (size_t)(ch + 1) * 16 * 16);
        f32x16 z;
#pragma unroll
        for (int i = 0; i < 16; ++i) z[i] = 0.f;
        f32x16 a0 = MFMA32(af, bfr[0], z), a1 = MFMA32(af, bfr[1], z), a2 = MFMA32(af, bfr[2], z), a3 = MFMA32(af, bfr[3], z);
        if (FULL) *(h16x8*)(us + (aseq * 16 + att) * 32 + hf * 16) = af;
#pragma unroll
        for (int i = 0; i < 16; ++i) {
            const float nr0 = fmaf(are0, hr0, fmaf(-aim0, hi0, a0[i]));
            const float ni0 = fmaf(are0, hi0, fmaf(aim0, hr0, a2[i]));
            const float nr1 = fmaf(are1, hr1, fmaf(-aim1, hi1, a1[i]));
            const float ni1 = fmaf(are1, hi1, fmaf(aim1, hr1, a3[i]));
            hr0 = nr0; hi0 = ni0; hr1 = nr1; hi1 = ni1;
            if (FULL) {
                h16x4 hv; hv[0] = (h16)hr0; hv[1] = (h16)hr1; hv[2] = (h16)hi0; hv[3] = (h16)hi1;
                *(h16x4*)(ldsw + (hf * 16 + i) * 272 + q * 8) = hv;
            }
        }
        if (FULL) {
            asm volatile("s_waitcnt lgkmcnt(0)" ::: "memory");
            __builtin_amdgcn_wave_barrier();
#pragma unroll
            for (int sq = 0; sq < 2; ++sq) {
                f32x4 y; y[0] = 0.f; y[1] = 0.f; y[2] = 0.f; y[3] = 0.f;
#pragma unroll
                for (int ks = 0; ks < 4; ++ks) {
                    const h16x8 hfr = *(const h16x8*)(ldsw + (sq * 16 + c16) * 272 + (32 * ks + 8 * l4) * 2);
                    y = MFMA16(cfr[ks], hfr, y);
                }
                const h16x4 uu = *(const h16x4*)(us + (sq * 16 + c16) * 32 + l4 * 8);
                h16x4 ov;
                ov[0] = (h16)geluf_(y[0] * (1.f / 1024.f) + d4.x * (float)uu[0]);
                ov[1] = (h16)geluf_(y[1] * (1.f / 1024.f) + d4.y * (float)uu[1]);
                ov[2] = (h16)geluf_(y[2] * (1.f / 1024.f) + d4.z * (float)uu[2]);
                ov[3] = (h16)geluf_(y[3] * (1.f / 1024.f) + d4.w * (float)uu[3]);
                *(h16x4*)(yg + (size_t)g * TOK * 16 + ((size_t)(2 * bp + sq) * SEQ + s * 128 + ch * 16 + c16) * 16 + 4 * l4) = ov;
            }
            asm volatile("s_waitcnt lgkmcnt(0)" ::: "memory");
            __builtin_amdgcn_wave_barrier();
        }
    }
    if (!FULL) E[eidx + (size_t)s * 64] = make_float4(hr0, hr1, hi0, hi1);
}

#define XB_TMO      128
#define XB_XCNT(j)  (256  + 64 * (j))
#define XB_XSUB(j)  (1280 + 64 * (j))
#define XB_XGEN(j)  (2304 + 64 * (j))
#define XB_TOP      3328
#define XB_TOPGEN   3392
#define XCD_BAR_WORDS 3456
#define XB_SPIN_CAP (1u << 22)
#define LAS __attribute__((address_space(3)))
DI unsigned xb_ld(unsigned* p) { return __hip_atomic_load(p, __ATOMIC_RELAXED, __HIP_MEMORY_SCOPE_AGENT); }
DI unsigned xb_add(unsigned* p, unsigned v) { return __hip_atomic_fetch_add(p, v, __ATOMIC_RELAXED, __HIP_MEMORY_SCOPE_AGENT); }
DI unsigned xb_xcc_id() { return (unsigned)__builtin_amdgcn_s_getreg((3 << 11) | 20) & 0xFu; }
#define XB_SPIN(cond, bar) do { unsigned _sp = 0; while (cond) { __builtin_amdgcn_s_sleep(1); \
    if ((++_sp & 255u) == 0u) { if (xb_ld(&(bar)[XB_TMO])) break; if (_sp > XB_SPIN_CAP) { atomicAdd(&(bar)[XB_TMO], 1u); break; } } } } while (0)
struct XcdBarrier { unsigned* bar; unsigned x; volatile LAS unsigned* st; };
DI XcdBarrier xcd_barrier_post(unsigned* bar, volatile LAS unsigned* st) {
    XcdBarrier b; b.bar = bar; b.x = xb_xcc_id(); b.st = st;
    if (threadIdx.x == 0) (void)xb_add(&bar[XB_XCNT(b.x)], 1u);
    return b;
}
DI void xcd_barrier_complete(unsigned* bar, unsigned x, unsigned& nloc, unsigned& nx) {
    const unsigned G = gridDim.x * gridDim.y * gridDim.z;
    unsigned sum, cnt, mine, sp = 0u;
    for (;;) {
        sum = 0u; cnt = 0u; mine = 0u;
#pragma unroll
        for (unsigned j = 0; j < 16; ++j) { const unsigned c = xb_ld(&bar[XB_XCNT(j)]); sum += c; cnt += (c > 0u) ? 1u : 0u; mine = (j == x) ? c : mine; }
        if (sum == G) break;
        __builtin_amdgcn_s_sleep(1);
        if ((++sp & 255u) == 0u) { if (xb_ld(&bar[XB_TMO])) break; if (sp > XB_SPIN_CAP) { atomicAdd(&bar[XB_TMO], 1u); break; } }
    }
    nloc = mine > 0u ? mine : 1u; nx = cnt > 0u ? cnt : 1u;
}
DI void xcd_barrier(const XcdBarrier& b) {
    asm volatile("s_waitcnt vmcnt(0)" ::: "memory");
    __syncthreads();
    if (threadIdx.x == 0) {
        unsigned* bar = b.bar;
        __builtin_amdgcn_s_waitcnt(0);
        unsigned nloc = b.st[0], nx = b.st[1];
        if (nloc == 0u) { xcd_barrier_complete(bar, b.x, nloc, nx); b.st[0] = nloc; b.st[1] = nx; }
        const unsigned old = xb_add(&bar[XB_XSUB(b.x)], 1u);
        const unsigned gen = old / nloc;
        if (old + 1u == (gen + 1u) * nloc) {
            __builtin_amdgcn_fence(__ATOMIC_RELEASE, "agent");
            asm volatile("s_waitcnt vmcnt(0)" ::: "memory");
            const unsigned og = xb_add(&bar[XB_TOP], 1u);
            const unsigned tg = og / nx;
            if (og + 1u == (tg + 1u) * nx) xb_add(&bar[XB_TOPGEN], 1u);
            else XB_SPIN(xb_ld(&bar[XB_TOPGEN]) == tg, bar);
            __builtin_amdgcn_fence(__ATOMIC_ACQUIRE, "agent");
            xb_add(&bar[XB_XGEN(b.x)], 1u);
            asm volatile("s_waitcnt vmcnt(0)" ::: "memory");
        } else {
            XB_SPIN(xb_ld(&bar[XB_XGEN(b.x)]) == gen, bar);
            __builtin_amdgcn_fence(__ATOMIC_ACQUIRE, "agent");
            asm volatile("s_waitcnt vmcnt(0)" ::: "memory");
        }
    }
    __syncthreads();
}

DI bool tile_map(int bid, int nblk, int it, int NT, int& mt, int& nt) {
    const int x = bid & 7, li = bid >> 3, nper = nblk >> 3;
    const int n = li + it * nper;
    if (n >= 16 * NT) return false;
    mt = x * 16 + (n / (8 * NT)) * 8 + (n & 7);
    nt = (n >> 3) % NT;
    return true;
}

__global__ void __launch_bounds__(256, 2) mega(P p, int lo, int hi) {
    __shared__ __attribute__((aligned(16))) char lds[LDS_BYTES];
    cg::grid_group grid = cg::this_grid();
#define IDS const int tid = threadIdx.x, lane = tid & 63, wave = __builtin_amdgcn_readfirstlane(tid >> 6), q = lane & 31, hf = lane >> 5; const int bid = blockIdx.x, nblk = gridDim.x; (void)lane; (void)wave; (void)q; (void)hf; (void)bid; (void)nblk;
    int* ctr = (int*)(p.ws + OFF_CTR);
    h16* obuf = (h16*)(p.ws + OFF_OBUF);
    const float* rs = (const float*)(lds + LDS_RS);

#ifndef ONLY
#define ONLY -1
#endif
#define RUN(k) ((ONLY < 0 || ONLY == (k)) && lo <= (k) && (k) < hi)
#define SYNC(k) if (RUN(k) && RUN((k) + 1)) xcd_barrier(xb);
    if (threadIdx.x < 4) ((volatile LAS unsigned*)(lds + LDS_XB))[threadIdx.x] = 0u;
    __syncthreads();
    XcdBarrier xb = xcd_barrier_post((unsigned*)(p.ws + OFF_BAR), (volatile LAS unsigned*)(lds + LDS_XB));
    if (hi > 1000) grid.sync();
    if (RUN(0)) {
            IDS
            for (int rep = 0; rep < NREP(0); ++rep)
            { int rot = 0; for (int m = 0; m < 7; ++m) rot += conv_matrix(p, m, bid, nblk, (float*)lds, tid, rot); }
            rmsnorm_rows(p.x, p.ln_gain, (h16*)(p.ws + OFF_XN0), TOK, bid * 4 + wave, nblk * 4, lane);
            rmsnorm_rows(p.mem, p.mem_norm, (h16*)(p.ws + OFF_MEMN0), 2048, bid * 4 + wave, nblk * 4, lane);
            rmsnorm_rows(p.mem, p.mem_norm + DM, (h16*)(p.ws + OFF_MEMN1), 2048, bid * 4 + wave, nblk * 4, lane);
            s5_tables(p, bid * 256 + tid, nblk * 256);
            for (int i = bid * 256 + tid; i < 3 * TOK; i += nblk * 256) ((float*)(p.ws + OFF_ROWSS))[i] = 0.f;
    }
    SYNC(0)
    if (RUN(1)) {
            IDS
            const h16* xn = (const h16*)(p.ws + OFF_XN0);
            const h16* w = (const h16*)(p.ws + OFF_WIN0);
            for (int rep = 0; rep < NREP(1); ++rep)
            for (int it = 0;; ++it) {
                int mt, nt;
                if (!tile_map256(bid, nblk, it, 32, mt, nt)) break;
                const int m0 = mt * 256, n0 = nt * 128;
                f32x16 acc2[2][4];
                gemm_tile256<true>(xn + (size_t)m0 * DM, DM, w + (size_t)n0 * DM, DM, DM, lds, acc2, tid);
                __syncthreads();
                char* stg = lds + wave * 8704;
                const size_t rw = (size_t)(m0 + wave * 64);
                const int mode = (n0 < 1536) ? 0 : (n0 < 2048 ? 1 : 2);
                h16* dst = (n0 < 1536) ? (h16*)(p.ws + OFF_U) + (size_t)(n0 >> 4) * TOK * 16 + rw * 16
                         : (n0 < 2048) ? (h16*)(p.ws + OFF_XQ0) + rw * 512 + (n0 - 1536) : obuf + rw * 2048 + (n0 - 2048);
                const int ld = (n0 < 1536) ? 0 : (n0 < 2048 ? 512 : 2048);
                const int hstep = (n0 < 1536) ? 32 * 16 : 32 * ld;
#pragma unroll
                for (int hh = 0; hh < 2; ++hh) t_epi(acc2[hh], mode, p.xq_norm, 1.f, stg, dst + (size_t)hh * hstep, ld, q, hf, lane);
            }
            for (int t2 = bid; t2 < 256; t2 += nblk) {
                f32x16 acc[4];
                const int layer = t2 >> 7, mt = (t2 >> 3) & 15, nt = t2 & 7;
                const h16* mn = (const h16*)(p.ws + (layer ? OFF_MEMN1 : OFF_MEMN0));
                const h16* wm = (const h16*)(p.ws + (layer ? OFF_WMKV1 : OFF_WMKV0));
                const int m0 = mt * 128, b = m0 >> 8, key0 = m0 & 255;
                if (nt < 4) {
                    gemm_tile<true>(mn + (size_t)m0 * DM, DM, wm + (size_t)(nt * 128) * DM, DM, DM, lds, acc, tid);
                    h16* mk = (h16*)(p.ws + (layer ? OFF_MEMK1 : OFF_MEMK0));
                    __syncthreads();
                    char* stg = lds + wave * 8704;
                    t_norm128(acc, 1.f, (h16*)(stg + q * 272), hf);
                    t_flush128g(stg, mk + (size_t)((b * 4 + nt) * 256 + key0 + wave * 32) * 128, 128, p.xk_norm + layer * 128, lane);
                } else {
                    const int h = nt - 4;
                    gemm_tile<false>(mn + (size_t)m0 * DM, DM, wm + (size_t)(512 + h * 128) * DM, DM, DM, lds, acc, tid);
                    h16* mvt = (h16*)(p.ws + (layer ? OFF_MEMVT1 : OFF_MEMVT0)) + (size_t)((b * 4 + h) * 128) * 256 + key0 + wave * 32 + 4 * hf;
#pragma unroll
                    for (int j = 0; j < 4; ++j)
#pragma unroll
                        for (int g4 = 0; g4 < 4; ++g4) {
                            h16x4 v;
#pragma unroll
                            for (int e = 0; e < 4; ++e) v[e] = (h16)acc[j][4 * g4 + e];
                            *(h16x4*)(mvt + (size_t)(32 * j + q) * 256 + 8 * g4) = v;
                        }
                }
            }
    }
    SYNC(1)
    if (RUN(2)) {
            IDS
            for (int it = bid * 4 + wave; it < 6144; it += 4 * nblk)
                if ((it & 15) != 15) s5_seg<false>(p, it >> 6, (it >> 4) & 3, it & 15, lds + wave * 9728, lane);
            mem_attn_phase(p, 0, ctr + 0, lds, tid);
    }
    SYNC(2)
    if (RUN(3)) {
            IDS
            for (int it = bid * 4 + wave; it < 6144; it += 4 * nblk)
                s5_seg<true>(p, it >> 6, (it >> 4) & 3, it & 15, lds + wave * 9728, lane);
    }
    SYNC(3)
    if (RUN(4)) {
            IDS
            const h16* ygp = (const h16*)(p.ws + OFF_YG);
            const h16* w = (const h16*)(p.ws + OFF_WGLU);
            for (int it = 0;; ++it) {
                int mt, nt;
                if (!tile_map256(bid, nblk, it, 24, mt, nt)) break;
                const int m0 = mt * 256;
                f32x16 acc2[2][4];
                gemm_tile256<true, true>(ygp + (size_t)m0 * 16, 0, w + (size_t)(nt * 128) * 1536, 1536, 1536, lds, acc2, tid);
                __syncthreads();
                char* stg = lds + wave * 8704;
#pragma unroll
                for (int hh = 0; hh < 2; ++hh) {
                    h16* srow = (h16*)(stg + q * 272) + 4 * hf;
#pragma unroll
                    for (int j = 0; j < 2; ++j)
#pragma unroll
                        for (int g4 = 0; g4 < 4; ++g4) {
                            h16x4 v;
#pragma unroll
                            for (int e = 0; e < 4; ++e) v[e] = (h16)(acc2[hh][j][4 * g4 + e] * sigmoidf_(acc2[hh][j + 2][4 * g4 + e]));
                            *(h16x4*)(srow + 32 * j + 8 * g4) = v;
                        }
                    t_flush64_mul(stg, obuf + (size_t)(m0 + wave * 64 + hh * 32) * 2048 + nt * 64, 2048, lane);
                }
            }
    }
    SYNC(4)
    if (RUN(5)) {
            IDS
            const h16* w = (const h16*)(p.ws + OFF_WOUT0);
            const float* xin = p.x;
            float* rowss = (float*)(p.ws + OFF_ROWSS);
            h16* xr = (h16*)(p.ws + OFF_XN1);
            for (int it = 0;; ++it) {
                int mt, nt;
                if (!tile_map256(bid, nblk, it, 8, mt, nt)) break;
                const int m0 = mt * 256, n0 = nt * 128;
                f32x16 acc2[2][4];
                gemm_tile256<false>(obuf + (size_t)m0 * 2048, 2048, w + (size_t)n0 * 2048, 2048, 2048, lds, acc2, tid);
                __syncthreads();
                char* stg = lds + wave * 8704;
#pragma unroll
                for (int hh = 0; hh < 2; ++hh) {
                    const int r0 = m0 + wave * 64 + hh * 32;
                    const size_t ob = (size_t)(r0 + 4 * hf) * DM + n0 + q;
                    float xv[16][4];
#pragma unroll
                    for (int i = 0; i < 16; ++i)
#pragma unroll
                        for (int j = 0; j < 4; ++j) xv[i][j] = __builtin_nontemporal_load(xin + ob + (size_t)((i & 3) + 8 * (i >> 2)) * DM + 32 * j);
#pragma unroll
                    for (int i = 0; i < 16; ++i) {
                        const int r = (i & 3) + 8 * (i >> 2);
                        float ss = 0.f;
#pragma unroll
                        for (int j = 0; j < 4; ++j) {
                            const float v = xv[i][j] + acc2[hh][j][i];
                            p.out[ob + (size_t)r * DM + 32 * j] = v;
                            *(h16*)(stg + (r + 4 * hf) * 272 + (32 * j + q) * 2) = (h16)v;
                            ss += v * v;
                        }
                        ss = half_sum(ss);
                        if (q == 0) atomicAdd(&rowss[r0 + r + 4 * hf], ss);
                    }
                    t_flush128(stg, xr + (size_t)r0 * DM + n0, DM, lane);
                }
            }
            { const int r7 = conv_matrix(p, 7, bid, nblk, (float*)lds, tid, 0); conv_matrix(p, 8, bid, nblk, (float*)lds, tid, r7); }
    }
    SYNC(5)
    if (RUN(7)) {
            IDS
            const h16* xn = (const h16*)(p.ws + OFF_XN1);
            const h16* w = (const h16*)(p.ws + OFF_WIN1);
            const float* rowss = (const float*)(p.ws + OFF_ROWSS);
            const int nper7 = nblk >> 3, full7 = (8 * 26) / nper7;
            for (int it = 0; it < full7; ++it) {
                int mt, nt;
                if (!tile_map256(bid, nblk, it, 26, mt, nt)) break;
                const int m0 = mt * 256, n0 = nt * 128;
                f32x16 acc2[2][4];
                gemm_tile256<true>(xn + (size_t)m0 * DM, DM, w + (size_t)n0 * DM, DM, DM, lds, acc2, tid);
                __syncthreads();
                char* stg = lds + wave * 8704;
                const size_t rw = (size_t)(m0 + wave * 64);
                {
                    const int mode = (nt < 6) ? 0 : (nt < 10 ? 1 : 2);
                    h16* dst = (nt < 4) ? (h16*)(p.ws + OFF_CQ) + rw * 512 + n0
                             : (nt < 6) ? (h16*)(p.ws + OFF_CKV) + rw * 256 + (n0 - 512)
                             : (nt < 10) ? (h16*)(p.ws + OFF_XQ1) + rw * 512 + (n0 - 768) : obuf + rw * 2048 + (n0 - 1280);
                    const int ld = (nt < 4) ? 512 : (nt < 6 ? 256 : (nt < 10 ? 512 : 2048));
#pragma unroll
                    for (int hh = 0; hh < 2; ++hh) {
                        const float pre = rsqrtf(rowss[rw + hh * 32 + q] * (1.f / DM) + EPS);
                        if (nt < 6) t_rowss(acc2[hh], pre, (float*)(p.ws + (nt < 4 ? OFF_ROWSS2 : OFF_ROWSS3)) + rw + hh * 32 + q, hf);
                        t_epi(acc2[hh], mode, p.xq_norm + 128, pre, stg, dst + (size_t)(hh * 32) * ld, ld, q, hf, lane);
                    }
                }
            }
            for (int st = (bid >> 3); st < 2 * (8 * 26 - full7 * nper7); st += nper7) {
                const int n = full7 * nper7 + (st >> 1), half = st & 1;
                const int mt = (bid & 7) * 8 + (n / (4 * 26)) * 4 + (n & 3), nt = (n >> 2) % 26;
                const int m0 = mt * 256 + half * 128, n0 = nt * 128;
                f32x16 acc[4];
                gemm_tile<true>(xn + (size_t)m0 * DM, DM, w + (size_t)n0 * DM, DM, DM, lds, acc, tid);
                __syncthreads();
                char* stg = lds + wave * 8704;
                const size_t rw = (size_t)(m0 + wave * 32);
                const int mode = (nt < 6) ? 0 : (nt < 10 ? 1 : 2);
                h16* dst = (nt < 4) ? (h16*)(p.ws + OFF_CQ) + rw * 512 + n0
                         : (nt < 6) ? (h16*)(p.ws + OFF_CKV) + rw * 256 + (n0 - 512)
                         : (nt < 10) ? (h16*)(p.ws + OFF_XQ1) + rw * 512 + (n0 - 768) : obuf + rw * 2048 + (n0 - 1280);
                const int ld = (nt < 4) ? 512 : (nt < 6 ? 256 : (nt < 10 ? 512 : 2048));
                const float pre = rsqrtf(rowss[rw + q] * (1.f / DM) + EPS);
                if (nt < 6) t_rowss(acc, pre, (float*)(p.ws + (nt < 4 ? OFF_ROWSS2 : OFF_ROWSS3)) + rw + q, hf);
                t_epi(acc, mode, p.xq_norm + 128, pre, stg, dst, ld, q, hf, lane);
            }
            for (int t2 = nblk - 1 - bid; t2 < 128; t2 += nblk) {
                f32x16 acc[4];
                const int m0 = t2 * 128;
                gemm_tile<true>(xn + (size_t)m0 * DM, DM, w + (size_t)(26 * 128) * DM, DM, DM, lds, acc, tid);
                const size_t row = (size_t)(m0 + wave * 32 + q);
                __syncthreads();
                char* stg = lds + wave * 8704;
                t_rope64(acc[0], acc[1], p.k_rope_norm, rsqrtf(rowss[row] * (1.f / DM) + EPS), (float)p.pos[row], (h16*)(stg + q * 272), hf);
                t_flush64(stg, (h16*)(p.ws + OFF_KR) + (size_t)(m0 + wave * 32) * 64, 64, lane);
            }
    }
    SYNC(7)
    if (RUN(8)) {
            IDS
            const h16* cq = (const h16*)(p.ws + OFF_CQ);
            const h16* w = (const h16*)(p.ws + OFF_WUQ);
            h16* Q = (h16*)(p.ws + OFF_Q);
            for (int it = 0;; ++it) {
                int mt, nt;
                if (!tile_map(bid, nblk, it, 18, mt, nt)) break;
                const int m0 = mt * 128;
                f32x16 acc[4];
                gemm_tile<true>(cq + (size_t)m0 * 512, 512, w + (size_t)(nt * 128) * 512, 512, 512, lds, acc, tid);
                const int b = m0 >> 11, l = (m0 & 2047) + wave * 32 + q;
                const float pre = rsqrtf(((const float*)(p.ws + OFF_ROWSS2))[m0 + wave * 32 + q] * (1.f / 512.f) + EPS);
                if (nt < 12) {
                    __syncthreads();
                    char* stg = lds + wave * 8704;
                    t_norm128(acc, pre, (h16*)(stg + q * 272), hf);
                    t_flush128g(stg, Q + ((size_t)(b * 12 + nt) * SEQ + (l - q)) * 192, 192, p.q_nope_norm, lane);
                } else {
                    const int hA = 2 * (nt - 12);
                    const float posf = (float)p.pos[m0 + wave * 32 + q];
                    __syncthreads();
                    char* stg = lds + wave * 8704;
                    t_rope64(acc[0], acc[1], p.q_rope_norm, pre, posf, (h16*)(stg + q * 272), hf);
                    t_flush64(stg, Q + ((size_t)(b * 12 + hA) * SEQ + (l - q)) * 192 + 128, 192, lane);
                    t_rope64(acc[2], acc[3], p.q_rope_norm, pre, posf, (h16*)(stg + q * 272), hf);
                    t_flush64(stg, Q + ((size_t)(b * 12 + hA + 1) * SEQ + (l - q)) * 192 + 128, 192, lane);
                }
            }
            mem_attn_phase(p, 1, ctr + 1, lds, tid);
    }
    SYNC(8)
    if (RUN(9)) {
            IDS
            const h16* ckv = (const h16*)(p.ws + OFF_CKV);
            const h16* w = (const h16*)(p.ws + OFF_WUKV);
            for (int it = 0;; ++it) {
                int mt, nt;
                if (!tile_map(bid, nblk, it, 24, mt, nt)) break;
                const int m0 = mt * 128, h = nt >> 1;
                f32x16 acc[4];
                const float* rss3 = (const float*)(p.ws + OFF_ROWSS3) + m0 + wave * 32;
                const int b = m0 >> 11, l0 = (m0 & 2047) + wave * 32;
                if ((nt & 1) == 0) {
                    gemm_tile<true>(ckv + (size_t)m0 * 256, 256, w + (size_t)(h * 256) * 256, 256, 256, lds, acc, tid);
                    h16* Kn = (h16*)(p.ws + OFF_KN);
                    __syncthreads();
                    char* stg = lds + wave * 8704;
                    t_norm128(acc, rsqrtf(rss3[q] * (1.f / 256.f) + EPS), (h16*)(stg + q * 272), hf);
                    t_flush128g(stg, Kn + ((size_t)(b * 12 + h) * SEQ + l0) * 128, 128, p.k_nope_norm, lane);
                } else {
                    gemm_tile<false>(ckv + (size_t)m0 * 256, 256, w + (size_t)(h * 256 + 128) * 256, 256, 256, lds, acc, tid);
                    __syncthreads();
                    {
                        char* img = lds + ((wave >> 1) * 128 + q) * 136 + ((wave & 1) * 32 + 4 * hf) * 2;
#pragma unroll
                        for (int g4 = 0; g4 < 4; ++g4) {
                            const float4 s4 = *(const float4*)(rss3 + 8 * g4 + 4 * hf);
                            float4 pr;
                            pr.x = rsqrtf(s4.x * (1.f / 256.f) + EPS); pr.y = rsqrtf(s4.y * (1.f / 256.f) + EPS);
                            pr.z = rsqrtf(s4.z * (1.f / 256.f) + EPS); pr.w = rsqrtf(s4.w * (1.f / 256.f) + EPS);
#pragma unroll
                            for (int j = 0; j < 4; ++j) {
                                h16x4 v;
                                v[0] = (h16)(acc[j][4 * g4 + 0] * pr.x); v[1] = (h16)(acc[j][4 * g4 + 1] * pr.y);
                                v[2] = (h16)(acc[j][4 * g4 + 2] * pr.z); v[3] = (h16)(acc[j][4 * g4 + 3] * pr.w);
                                *(h16x4*)(img + (32 * j) * 136 + 8 * g4 * 2) = v;
                            }
                        }
                    }
                    __syncthreads();
                    {
                        h16* Vt = (h16*)(p.ws + OFF_VT) + (size_t)(b * 12 + h) * 128 * SEQ + (size_t)((m0 & 2047) >> 6) * 8192;
#pragma unroll
                        for (int i = 0; i < 8; ++i) {
                            const int cidx = tid + 256 * i, row = cidx >> 3, c = cidx & 7;
                            *(h16x8*)(Vt + (size_t)row * 64 + c * 8) = *(const h16x8*)(lds + row * 136 + c * 16);
                        }
                    }
                }
            }
    }
    SYNC(9)
    if (RUN(10)) {
            IDS
            const h16* Q = (const h16*)(p.ws + OFF_Q);
            const h16* Kn = (const h16*)(p.ws + OFF_KN);
            const h16* Kr = (const h16*)(p.ws + OFF_KR);
            const h16* Vt = (const h16*)(p.ws + OFF_VT);
            volatile int* sitem = (volatile int*)(lds + LDS_ITEM);
            const float sc = 0.07216878364870322f * LOG2E;
            for (int rep = 0; rep < NREP(9); ++rep)
            for (;;) {
                __syncthreads();
                if (tid == 0) *sitem = atomicAdd(ctr + 2 + (NREP(9) - 1 - rep) * 4, 1);
                __syncthreads();
                const int it = *sitem;
                if (it >= 1536) break;
                const int qt = 15 - it / 96, bh = it % 96, b = bh / 12, h = bh % 12;
                const bool dummy = (rep + 1 < NREP(9));
                attn_item<192, true>(Q + ((size_t)bh * SEQ + qt * 128) * 192, 192, Kn + (size_t)bh * SEQ * 128, 128, Kr + (size_t)b * SEQ * 64,
                                     Vt + (size_t)bh * 128 * SEQ, 64, 8192, 2 * qt + 2, qt * 128,
                                     dummy ? (h16*)(p.ws + OFF_CKV) : obuf + ((size_t)b * SEQ + qt * 128) * 2048 + h * 128, dummy ? 0 : 2048, sc, lds, tid);
            }
    }
    SYNC(10)
    if (RUN(11)) {
            IDS
            const h16* w = (const h16*)(p.ws + OFF_WOUT1);
            const float* xin = p.out;
            for (int it = 0;; ++it) {
                int mt, nt;
                if (!tile_map256(bid, nblk, it, 8, mt, nt)) break;
                const int m0 = mt * 256, n0 = nt * 128;
                f32x16 acc2[2][4];
                gemm_tile256<false>(obuf + (size_t)m0 * 2048, 2048, w + (size_t)n0 * 2048, 2048, 2048, lds, acc2, tid);
#pragma unroll
                for (int hh = 0; hh < 2; ++hh) {
                    const size_t ob = (size_t)(m0 + wave * 64 + hh * 32 + 4 * hf) * DM + n0 + q;
                    float xv[16][4];
#pragma unroll
                    for (int i = 0; i < 16; ++i)
#pragma unroll
                        for (int j = 0; j < 4; ++j) xv[i][j] = __builtin_nontemporal_load(xin + ob + (size_t)((i & 3) + 8 * (i >> 2)) * DM + 32 * j);
#pragma unroll
                    for (int i = 0; i < 16; ++i)
#pragma unroll
                        for (int j = 0; j < 4; ++j) __builtin_nontemporal_store(xv[i][j] + acc2[hh][j][i], p.out + ob + (size_t)((i & 3) + 8 * (i >> 2)) * DM + 32 * j);
                }
            }
    }
}

extern "C" void kernel_launch(void* const* d_in, const int* in_sizes, int n_in, void* d_out, int out_size, void* d_ws, size_t ws_size,
                              hipStream_t stream) {
    static int grid = 0;
    if (!grid) {
        int dev = 0, cus = 0, per_cu = 0;
        hipGetDevice(&dev);
        hipDeviceGetAttribute(&cus, hipDeviceAttributeMultiprocessorCount, dev);
        hipOccupancyMaxActiveBlocksPerMultiprocessor(&per_cu, mega, 256, 0);
        if (per_cu < 1) per_cu = 1;
        if (per_cu > 2) per_cu = 2;
        grid = cus * per_cu;
    }
    P p{};
    p.x = (const float*)d_in[0]; p.mem = (const float*)d_in[1]; p.pos = (const int*)d_in[2];
    p.ln_gain = (const float*)d_in[3]; p.w_out = (const float*)d_in[4]; p.mem_norm = (const float*)d_in[5];
    p.w_mem_kv = (const float*)d_in[6]; p.xq_norm = (const float*)d_in[7]; p.xk_norm = (const float*)d_in[8];
    p.s5_w_in = (const float*)d_in[9]; p.lam_re = (const float*)d_in[10]; p.lam_im = (const float*)d_in[11];
    p.log_step = (const float*)d_in[12]; p.b_re = (const float*)d_in[13]; p.b_im = (const float*)d_in[14];
    p.c_re = (const float*)d_in[15]; p.c_im = (const float*)d_in[16]; p.s5_d = (const float*)d_in[17]; p.w_glu = (const float*)d_in[18];
    p.mla_w_in = (const float*)d_in[19]; p.q_lora_norm = (const float*)d_in[20]; p.kv_lora_norm = (const float*)d_in[21];
    p.w_uq = (const float*)d_in[22]; p.w_ukv = (const float*)d_in[23]; p.q_nope_norm = (const float*)d_in[24];
    p.k_nope_norm = (const float*)d_in[25]; p.q_rope_norm = (const float*)d_in[26]; p.k_rope_norm = (const float*)d_in[27];
    p.out = (float*)d_out; p.ws = (char*)d_ws;
    hipMemsetAsync(d_ws, 0, 32768, stream);
#if MULTI_LAUNCH
    for (int ph = 0; ph < 12; ++ph) hipLaunchKernelGGL(mega, dim3(grid), dim3(256), 0, stream, p, ph, ph + 1);
#else
    int lo = 0, hi = 12;
    void* args[] = {&p, &lo, &hi};
    hipError_t e = hipLaunchCooperativeKernel((void*)mega, dim3(grid), dim3(256), args, 0, stream);
    if (e != hipSuccess) fprintf(stderr, "cooperative launch failed: %s (grid %d)\n", hipGetErrorString(e), grid);
#endif
}
```
